# Optimizing an MI355X kernel written in HIP

```python
import jax, jax.numpy as jnp
from jax import lax
import numpy as np

D_MODEL = 1024
BATCH = 8
SEQ = 2048
DEPTH = 4

CTX_LEN = 256
GRID_W = 64
N_MOD = 9
D_FF = 2816
EPS = 1e-6
GDN_HEADS = 4
GDN_HEAD_DIM = 128
GDN_WIDTH = GDN_HEADS * GDN_HEAD_DIM
CONV_K = 5
CONV_PAD = CONV_K // 2
CHUNK = 64
MLA_HEADS = 8
MLA_NOPE = 64
MLA_ROPE = 32
MLA_V = 64
MLA_WIDTH = MLA_HEADS * MLA_V
Q_RANK = 384
KV_RANK = 256
ROPE_BASE = 10000.0
AXIS_DIM = MLA_ROPE // 2
Q_BLOCK = 128
MLA_SCALE = (MLA_NOPE + MLA_ROPE) ** -0.5
MIX_WIDTH = GDN_WIDTH + MLA_WIDTH
OFF_Q = 0
OFF_K = GDN_WIDTH
OFF_V = 2 * GDN_WIDTH
OFF_Z = 3 * GDN_WIDTH
OFF_A = 4 * GDN_WIDTH
OFF_B = OFF_A + 2 * GDN_HEADS
OFF_CQ = OFF_B + 2 * GDN_HEADS
OFF_CKV = OFF_CQ + Q_RANK
OFF_KR = OFF_CKV + KV_RANK
IN_COLS = OFF_KR + MLA_ROPE

kernel_name = "hybrid_gdn_mla_macaron_dit"


def rmsnorm(x, g):
    xf = x.astype(jnp.float32)
    y = xf * lax.rsqrt(jnp.mean(xf * xf, axis=-1, keepdims=True) + EPS)
    return (y * g.astype(jnp.float32)).astype(x.dtype)


def l2norm(x):
    xf = x.astype(jnp.float32)
    return (xf * lax.rsqrt(jnp.sum(xf * xf, axis=-1, keepdims=True) + EPS)).astype(x.dtype)


def pre_mod(x, g, m, slot):
    return rmsnorm(x, g) * (1 + m[:, None, 3 * slot + 1]) + m[:, None, 3 * slot]


def post_residual(x, y, g, m, slot, weight):
    return x + weight * m[:, None, 3 * slot + 2] * rmsnorm(y, g)


def ffn_sublayer(x, m, slot, g_pre, g_post, wg, wu, wd):
    h = pre_mod(x, g_pre, m, slot)
    y = (jax.nn.silu(h @ wg) * (h @ wu)) @ wd
    return post_residual(x, y, g_post, m, slot, 0.5)


def short_conv(u, w):
    C = u.shape[-1]
    y = lax.conv_general_dilated(u, w[:, None, :].astype(u.dtype), window_strides=(1,),
                                 padding=[(CONV_PAD, CONV_PAD)],
                                 dimension_numbers=('NWC', 'WIO', 'NWC'),
                                 feature_group_count=C)
    return jax.nn.silu(y)


def gated_delta_chunked(q, k, v, g, beta, S0):
    out_dtype = v.dtype
    q, k, v, g, beta = [u.astype(jnp.float32) for u in (q, k, v, g, beta)]
    B2, T, H, dk = q.shape
    dv = v.shape[-1]
    n = T // CHUNK

    def blocks(u):
        return u.reshape(B2, n, CHUNK, H, -1).transpose(0, 3, 1, 2, 4)

    qb, kb, vb = blocks(q), blocks(k), blocks(v)
    gb = g.reshape(B2, n, CHUNK, H).transpose(0, 3, 1, 2)
    bb = beta.reshape(B2, n, CHUNK, H).transpose(0, 3, 1, 2)
    G = jnp.cumsum(gb, axis=-1)
    diff = G[..., :, None] - G[..., None, :]
    idx = jnp.arange(CHUNK)
    incl = idx[:, None] >= idx[None, :]
    strict = idx[:, None] > idx[None, :]
    decay = jnp.where(incl, jnp.exp(jnp.where(incl, diff, 0.0)), 0.0)
    kk = jnp.einsum('bhnid,bhnjd->bhnij', kb, kb)
    A = jnp.where(strict, bb[..., :, None] * kk * decay, 0.0)
    eyeA = A + jnp.eye(CHUNK, dtype=A.dtype)
    eG = jnp.exp(G)
    rhs = jnp.concatenate([bb[..., None] * vb, (bb * eG)[..., None] * kb], axis=-1)
    sol = lax.linalg.triangular_solve(eyeA, rhs, left_side=True, lower=True,
                                      unit_diagonal=True)
    u0, w = sol[..., :dv], sol[..., dv:]
    qk = jnp.einsum('bhnid,bhnjd->bhnij', qb, kb) * decay
    q_dec = qb * eG[..., None]
    G_last = G[..., -1]
    k_dec = kb * jnp.exp(G_last[..., None] - G)[..., None]
    chunk_dec = jnp.exp(G_last)
    xs = tuple(jnp.moveaxis(u, 2, 0) for u in (q_dec, k_dec, qk, u0, w, chunk_dec))

    def step(S, inp):
        qd, kd, qkc, u0c, wc, gl = inp
        U = u0c - jnp.einsum('bhcd,bhde->bhce', wc, S)
        o = jnp.einsum('bhcd,bhde->bhce', qd, S) + jnp.einsum('bhij,bhje->bhie', qkc, U)
        S = gl[..., None, None] * S + jnp.einsum('bhcd,bhce->bhde', kd, U)
        return S, o

    S_fin, o = lax.scan(step, S0, xs)
    o = o.transpose(1, 0, 3, 2, 4).reshape(B2, T, H, dv)
    return o.astype(out_dtype), S_fin


def gdn_group(qkv, z, a, b, conv_w, a_log, dt_bias, out_norm, L):
    B, T, _ = qkv.shape
    qkv = jnp.concatenate([short_conv(qkv[:, :L], conv_w), short_conv(qkv[:, L:], conv_w)], axis=1)
    q = qkv[..., :GDN_WIDTH].reshape(B, T, GDN_HEADS, GDN_HEAD_DIM)
    k = qkv[..., GDN_WIDTH:2 * GDN_WIDTH].reshape(B, T, GDN_HEADS, GDN_HEAD_DIM)
    v = qkv[..., 2 * GDN_WIDTH:].reshape(B, T, GDN_HEADS, GDN_HEAD_DIM)
    q = l2norm(q) * (GDN_HEAD_DIM ** -0.5)
    k = l2norm(k)
    a = a.reshape(B, T, 2, GDN_HEADS)
    b = b.reshape(B, T, 2, GDN_HEADS)
    g = -jnp.exp(a_log) * jax.nn.softplus(a + dt_bias)
    beta = jax.nn.sigmoid(b)

    def flip(u):
        return u[:, ::-1]

    def bidir(qs, ks, vs, gs, bs, S0):
        qq = jnp.concatenate([qs, flip(qs)], 0)
        kk = jnp.concatenate([ks, flip(ks)], 0)
        vv = jnp.concatenate([vs, flip(vs)], 0)
        gg = jnp.concatenate([gs[:, :, 0], flip(gs[:, :, 1])], 0)
        be = jnp.concatenate([bs[:, :, 0], flip(bs[:, :, 1])], 0)
        o, S = gated_delta_chunked(qq, kk, vv, gg, be, S0)
        return o[:B] + flip(o[B:]), S

    S_zero = jnp.zeros((2 * B, GDN_HEADS, GDN_HEAD_DIM, GDN_HEAD_DIM), jnp.float32)
    o_c, S_c = bidir(q[:, :L], k[:, :L], v[:, :L], g[:, :L], beta[:, :L], S_zero)
    o_l, _ = bidir(q[:, L:], k[:, L:], v[:, L:], g[:, L:], beta[:, L:], S_c)
    o = jnp.concatenate([o_c, o_l], axis=1)
    o = rmsnorm(o, out_norm) * jax.nn.silu(z.reshape(B, T, GDN_HEADS, GDN_HEAD_DIM))
    return o.reshape(B, T, GDN_WIDTH)


def rope2d(x, cos, sin):
    half = MLA_ROPE // 2
    x1, x2 = x[..., :half], x[..., half:]
    return jnp.concatenate([x1 * cos - x2 * sin, x2 * cos + x1 * sin], axis=-1).astype(x.dtype)


def attend(q, k, v):
    s = jnp.einsum('bqhd,bkhd->bhqk', q, k).astype(jnp.float32) * MLA_SCALE
    p = jax.nn.softmax(s, axis=-1)
    return jnp.einsum('bhqk,bkhd->bqhd', p.astype(v.dtype), v)


def mla_group(c_q, c_kv, k_rope, q_norm, kv_norm, w_uq, w_ukv, cos, sin, L):
    B, T, _ = c_q.shape
    q = (rmsnorm(c_q, q_norm) @ w_uq).reshape(B, T, MLA_HEADS, MLA_NOPE + MLA_ROPE)
    kv = (rmsnorm(c_kv, kv_norm) @ w_ukv).reshape(B, T, MLA_HEADS, MLA_NOPE + MLA_V)
    q_nope, q_rope = q[..., :MLA_NOPE], q[..., MLA_NOPE:]
    k_nope, v = kv[..., :MLA_NOPE], kv[..., MLA_NOPE:]
    q_rope = jnp.concatenate([q_rope[:, :L], rope2d(q_rope[:, L:], cos[:, None], sin[:, None])], axis=1)
    k_rope = jnp.concatenate([k_rope[:, :L], rope2d(k_rope[:, L:], cos, sin)], axis=1)
    qf = jnp.concatenate([q_nope, q_rope], axis=-1)
    kf = jnp.concatenate([k_nope, jnp.broadcast_to(k_rope[:, :, None], (B, T, MLA_HEADS, MLA_ROPE))], axis=-1)
    o_c = attend(qf[:, :L], kf[:, :L], v[:, :L])
    S = T - L
    nb = S // Q_BLOCK
    ql = qf[:, L:].reshape(B, nb, Q_BLOCK, MLA_HEADS, MLA_NOPE + MLA_ROPE).transpose(1, 0, 2, 3, 4)
    o_l = lax.map(lambda qb: attend(qb, kf, v), ql)
    o_l = o_l.transpose(1, 0, 2, 3, 4).reshape(B, S, MLA_HEADS, MLA_V)
    return jnp.concatenate([o_c, o_l], axis=1).reshape(B, T, MLA_WIDTH)


def mixer(h_c, h_l, w_in, conv_w, a_log, dt_bias, out_norm, q_norm, kv_norm, w_uq, w_ukv, w_out, cos, sin):
    L = h_c.shape[1]
    h = jnp.concatenate([h_c, h_l], axis=1)
    p = h @ w_in
    o_gdn = gdn_group(p[..., OFF_Q:OFF_Z], p[..., OFF_Z:OFF_A], p[..., OFF_A:OFF_B],
                      p[..., OFF_B:OFF_CQ], conv_w, a_log, dt_bias, out_norm, L)
    o_mla = mla_group(p[..., OFF_CQ:OFF_CKV], p[..., OFF_CKV:OFF_KR], p[..., OFF_KR:IN_COLS],
                      q_norm, kv_norm, w_uq, w_ukv, cos, sin, L)
    o = jnp.concatenate([o_gdn, o_mla], axis=-1) @ w_out
    return o[:, :L], o[:, L:]


def setup_inputs(seed: int = 0) -> dict:
    key = jax.random.key(seed)
    ks = jax.random.split(key, 24)
    f32 = jnp.float32

    def nrm(k, shape, fan):
        return jax.random.normal(k, shape, f32) * (fan ** -0.5)

    def gain(k, shape):
        return 1.0 + 0.05 * jax.random.normal(k, shape, f32)

    dt = jnp.exp(jax.random.uniform(ks[10], (DEPTH, 2, GDN_HEADS), f32,
                                    minval=np.log(0.001), maxval=np.log(0.1)))
    return {
        "x": jax.random.normal(ks[0], (BATCH, SEQ, D_MODEL), f32),
        "c": jax.random.normal(ks[1], (BATCH, D_MODEL), f32),
        "ctx": jax.random.normal(ks[2], (BATCH, CTX_LEN, D_MODEL), f32),
        "c_ctx": jax.random.normal(ks[3], (D_MODEL,), f32),
        "w_ada": 0.5 * nrm(ks[4], (DEPTH, D_MODEL, N_MOD * D_MODEL), D_MODEL),
        "b_ada": 0.02 * jax.random.normal(ks[5], (DEPTH, N_MOD * D_MODEL), f32),
        "norm_pre": gain(ks[6], (DEPTH, 3, D_MODEL)),
        "norm_post": gain(ks[7], (DEPTH, 3, D_MODEL)),
        "ffn_w_gate": nrm(ks[8], (DEPTH, 2, D_MODEL, D_FF), D_MODEL),
        "ffn_w_up": nrm(ks[9], (DEPTH, 2, D_MODEL, D_FF), D_MODEL),
        "ffn_w_down": nrm(ks[11], (DEPTH, 2, D_FF, D_MODEL), D_FF),
        "w_in": nrm(ks[12], (DEPTH, D_MODEL, IN_COLS), D_MODEL),
        "gdn_conv": nrm(ks[13], (DEPTH, CONV_K, 3 * GDN_WIDTH), CONV_K),
        "gdn_a_log": jnp.log(jax.random.uniform(ks[14], (DEPTH, 2, GDN_HEADS), f32, minval=1.0, maxval=16.0)),
        "gdn_dt_bias": dt + jnp.log(-jnp.expm1(-dt)),
        "gdn_out_norm": gain(ks[15], (DEPTH, GDN_HEAD_DIM)),
        "mla_q_norm": gain(ks[16], (DEPTH, Q_RANK)),
        "mla_kv_norm": gain(ks[17], (DEPTH, KV_RANK)),
        "mla_w_uq": nrm(ks[18], (DEPTH, Q_RANK, MLA_HEADS * (MLA_NOPE + MLA_ROPE)), Q_RANK),
        "mla_w_ukv": nrm(ks[19], (DEPTH, KV_RANK, MLA_HEADS * (MLA_NOPE + MLA_V)), KV_RANK),
        "w_out": nrm(ks[20], (DEPTH, MIX_WIDTH, D_MODEL), MIX_WIDTH),
    }


def reference(x, c, ctx, c_ctx, w_ada, b_ada, norm_pre, norm_post, ffn_w_gate, ffn_w_up,
              ffn_w_down, w_in, gdn_conv, gdn_a_log, gdn_dt_bias, gdn_out_norm, mla_q_norm,
              mla_kv_norm, mla_w_uq, mla_w_ukv, w_out):
    B, S, D = x.shape
    ROWS = S // GRID_W
    row = jnp.repeat(jnp.arange(ROWS), GRID_W).astype(jnp.float32)
    col = jnp.tile(jnp.arange(GRID_W), ROWS).astype(jnp.float32)
    inv_freq = jnp.power(ROPE_BASE, -jnp.arange(0, AXIS_DIM, 2, dtype=jnp.float32) / AXIS_DIM)
    ang = jnp.concatenate([row[:, None] * inv_freq, col[:, None] * inv_freq], axis=-1)
    cos, sin = jnp.cos(ang), jnp.sin(ang)

    s_lat = jax.nn.silu(c)
    s_ctx = jax.nn.silu(c_ctx)[None]
    xc, xl = ctx, x
    for l in range(DEPTH):
        last = l == DEPTH - 1
        m_l = (s_lat @ w_ada[l] + b_ada[l]).reshape(B, N_MOD, D)
        m_c = (s_ctx @ w_ada[l] + b_ada[l]).reshape(1, N_MOD, D)
        xc = ffn_sublayer(xc, m_c, 0, norm_pre[l, 0], norm_post[l, 0], ffn_w_gate[l, 0], ffn_w_up[l, 0], ffn_w_down[l, 0])
        xl = ffn_sublayer(xl, m_l, 0, norm_pre[l, 0], norm_post[l, 0], ffn_w_gate[l, 0], ffn_w_up[l, 0], ffn_w_down[l, 0])
        hc = pre_mod(xc, norm_pre[l, 1], m_c, 1)
        hl = pre_mod(xl, norm_pre[l, 1], m_l, 1)
        oc, ol = mixer(hc, hl, w_in[l], gdn_conv[l], gdn_a_log[l], gdn_dt_bias[l], gdn_out_norm[l],
                       mla_q_norm[l], mla_kv_norm[l], mla_w_uq[l], mla_w_ukv[l], w_out[l], cos, sin)
        xl = post_residual(xl, ol, norm_post[l, 1], m_l, 1, 1.0)
        xl = ffn_sublayer(xl, m_l, 2, norm_pre[l, 2], norm_post[l, 2], ffn_w_gate[l, 1], ffn_w_up[l, 1], ffn_w_down[l, 1])
        if not last:
            xc = post_residual(xc, oc, norm_post[l, 1], m_c, 1, 1.0)
            xc = ffn_sublayer(xc, m_c, 2, norm_pre[l, 2], norm_post[l, 2], ffn_w_gate[l, 1], ffn_w_up[l, 1], ffn_w_down[l, 1])
    return xl
```

```cpp
#include <hip/hip_runtime.h>
#include <hip/hip_cooperative_groups.h>
#include <cstdio>
#include <cstdint>
namespace cg = cooperative_groups;
#ifndef PROBE_MASK
#define PROBE_MASK 0
#endif
namespace pg8 {
#define PG8_LAS __attribute__((address_space(3)))
typedef unsigned short bf16_t;
typedef short bf16x8 __attribute__((ext_vector_type(8)));
typedef float f32x4 __attribute__((ext_vector_type(4)));
typedef unsigned u32x4 __attribute__((ext_vector_type(4)));
constexpr int BM = 256, BK = 64, HALF = 128, HTB = HALF * BK * 2  , STAGE_BYTES = 8 * HTB, NXCD = 8, WGM = 8;

__host__ __device__ __forceinline__ int lds_byte(int r, int c) { const int st = (r >> 4) * 2 + (c >> 5), rr = r & 15, cc = c & 31, ob = rr * 64 + cc * 2; return st * 1024 + (ob ^ (((ob >> 9) & 1) << 5)); }
__host__ __device__ __forceinline__ void stage_rc(int b, int& R, int& C) { const int st = b / 1024, sb = b % 1024, swz = sb ^ (((sb >> 9) & 1) << 5); R = (st >> 1) * 16 + swz / 64; C = (st & 1) * 32 + (swz % 64) / 2; }
__host__ __device__ __forceinline__ int perm32(int rho) { const int n = rho >> 4, i = rho & 15; return 8 * (i >> 2) + 4 * n + (i & 3); }

struct Unit { int pm, pn; };
struct Gemm { const bf16_t* A; const bf16_t* Bt; int M, N, K; };

struct StaticOrder {
    int nM, nN, nwg, G, c;
    __host__ __device__ void init(int M, int N, int G_, int c_) { nM = M / BM; nN = N / BM; nwg = nM * nN; G = G_; c = c_; }
    __host__ __device__ bool next(int i, Unit& u) const {
        const long L = (long)i * G + c; if (L >= nwg) return false;
        int wgid = (int)L; { const int q = nwg / NXCD, r = nwg % NXCD, xcd = wgid % NXCD, off = wgid / NXCD; wgid = (xcd < r ? xcd * (q + 1) : r * (q + 1) + (xcd - r) * q) + off; }
        const int nig = WGM * nN, gid = wgid / nig, fm = gid * WGM, gsz = (nM - fm) < WGM ? (nM - fm) : WGM;
        u.pm = fm + ((wgid % nig) % gsz); u.pn = (wgid % nig) / gsz; return true;
    }
    __device__ __forceinline__ void a_ready(const Unit&) const {}
    __device__ __forceinline__ void done(const Unit&) const {}
};
template <class Epi, class Sched, bool ALIGN_EPI = false, bool SP2 = false>
__device__ __forceinline__ void gemm_phase(PG8_LAS unsigned char* lds, const Gemm g, const Sched& S, const Epi& E) {
    int tid_l = threadIdx.x; asm volatile("" : "+v"(tid_l));
    const int tid = tid_l, wid = __builtin_amdgcn_readfirstlane(tid >> 6), lane = tid & 63, wr = wid >> 2, wc = wid & 3, fr = lane & 15, fq = lane >> 4;
    const int K = g.K, nt = K / BK;
    unsigned voffA[2], voffB[2];
#pragma unroll
    for (int i = 0; i < 2; ++i) { int R, C; stage_rc(tid * 16 + i * 8192, R, C); const int Rb = Epi::PERM ? ((R & ~31) + perm32(R & 31)) : R;
        voffA[i] = (unsigned)(R * K + C) * 2u; voffB[i] = (unsigned)(Rb * K + C) * 2u; }
    const size_t kstep = (size_t)(BK * 2);
    const size_t hstep = (size_t)HALF * K * 2;
    const size_t tstep = 2 * hstep;
    const unsigned ldsw = (unsigned)wid * 1024u;
    const int aoff = lds_byte(wr * 64 + fr, fq * 8), boff = lds_byte(wc * 32 + fr, fq * 8);
#define PG8_SA(b, h) (((b) * 2 + (h)) * HTB)
#define PG8_SB(b, h) ((4 + (b) * 2 + (h)) * HTB)
#define PG8_STAGE(bufoff, gbase, voff) do { _Pragma("unroll") for (int _i = 0; _i < 2; ++_i) \
        __builtin_amdgcn_global_load_lds((const unsigned*)((const char*)(gbase) + (voff)[_i]), (PG8_LAS unsigned*)(lds + (bufoff) + ldsw + _i * 8192), 16, 0, 0); } while (0)
#define PG8_LDA(dst, b, h) do { _Pragma("unroll") for (int m = 0; m < 4; ++m) _Pragma("unroll") for (int k = 0; k < 2; ++k) dst[m][k] = *(const PG8_LAS bf16x8*)(lds + PG8_SA(b, h) + aoff + m * 2048 + k * 1024); } while (0)
#define PG8_LDB(dst, b, h) do { _Pragma("unroll") for (int n = 0; n < 2; ++n) _Pragma("unroll") for (int k = 0; k < 2; ++k) dst[n][k] = *(const PG8_LAS bf16x8*)(lds + PG8_SB(b, h) + boff + n * 2048 + k * 1024); } while (0)
#define PG8_MMA(ai, bj, At, Bt) do { __builtin_amdgcn_s_setprio(1); _Pragma("unroll") for (int m = 0; m < 4; ++m) _Pragma("unroll") for (int n = 0; n < 2; ++n) _Pragma("unroll") for (int k = 0; k < 2; ++k) \
        acc[ai][bj][m][n] = __builtin_amdgcn_mfma_f32_16x16x32_bf16(Bt[n][k], At[m][k], acc[ai][bj][m][n], 0, 0, 0); __builtin_amdgcn_s_setprio(0); } while (0)
#define PG8_WAIT_V(n) asm volatile("s_waitcnt vmcnt(" #n ")" ::: "memory")
#define PG8_WAIT_L(n) asm volatile("s_waitcnt lgkmcnt(" #n ")" ::: "memory")
#define PG8_BAR __builtin_amdgcn_s_barrier()
#define PG8_SCHED __builtin_amdgcn_sched_barrier(0)
    Unit cur, nxt; int ui = 0;
    if (!S.next(0, cur)) return;
    f32x4 acc[2][2][4][2];
#pragma unroll
    for (int a = 0; a < 2; ++a)
#pragma unroll
        for (int b = 0; b < 2; ++b)
#pragma unroll
            for (int m = 0; m < 4; ++m)
#pragma unroll
                for (int n = 0; n < 2; ++n) acc[a][b][m][n] = (f32x4){0.f, 0.f, 0.f, 0.f};
    bf16x8 At[4][2], B0[2][2], B1[2][2];
    const char* cA = (const char*)g.A + (size_t)cur.pm * tstep; const char* cB = (const char*)g.Bt + (size_t)cur.pn * tstep;
    S.a_ready(cur);
    if constexpr (SP2) {
        PG8_STAGE(PG8_SB(0, 0), cB, voffB); PG8_STAGE(PG8_SB(0, 1), cB + hstep, voffB); PG8_STAGE(PG8_SA(0, 0), cA, voffA); PG8_STAGE(PG8_SA(0, 1), cA + hstep, voffA);
        if (wr == 1) PG8_BAR;
        PG8_WAIT_V(2); PG8_BAR;
        PG8_STAGE(PG8_SB(1, 0), cB + kstep, voffB); PG8_STAGE(PG8_SA(1, 0), cA + kstep, voffA); PG8_STAGE(PG8_SB(1, 1), cB + hstep + kstep, voffB);
        PG8_WAIT_V(6); PG8_BAR;
    } else {
        PG8_STAGE(PG8_SB(0, 0), cB, voffB); PG8_STAGE(PG8_SA(0, 0), cA, voffA); PG8_STAGE(PG8_SB(0, 1), cB + hstep, voffB); PG8_STAGE(PG8_SA(0, 1), cA + hstep, voffA);
        if (wr == 1) PG8_BAR;
        PG8_WAIT_V(4); PG8_BAR;
        PG8_STAGE(PG8_SB(1, 0), cB + kstep, voffB); PG8_STAGE(PG8_SA(1, 0), cA + kstep, voffA); PG8_STAGE(PG8_SB(1, 1), cB + hstep + kstep, voffB);
        PG8_WAIT_V(6); PG8_BAR;
    }
    for (;;) {
        const bool has_next = S.next(ui + 1, nxt);
        const char* nA = has_next ? (const char*)g.A + (size_t)nxt.pm * tstep : cA; const char* nB = has_next ? (const char*)g.Bt + (size_t)nxt.pn * tstep : cB;
_Pragma("unroll 1")
        for (int t = 0; t < nt; t += 2) {
            const bool last = (t == nt - 2);
            const char* a1 = cA + (size_t)(t + 1) * kstep;
            const char* a2 = last ? nA : cA + (size_t)(t + 2) * kstep; const char* b2 = last ? nB : cB + (size_t)(t + 2) * kstep;
            const char* a3 = a2 + kstep; const char* b3 = b2 + kstep;
            if (last && has_next) S.a_ready(nxt);
            if constexpr (SP2) {
            PG8_LDB(B0, 0, 0); PG8_LDB(B1, 0, 1); PG8_SCHED; PG8_LDA(At, 0, 0); PG8_STAGE(PG8_SA(1, 1), a1 + hstep, voffA);
            PG8_WAIT_V(8); PG8_WAIT_L(0); PG8_BAR; PG8_MMA(0, 0, At, B0); PG8_MMA(0, 1, At, B1); PG8_BAR; PG8_SCHED;
            PG8_LDA(At, 0, 1); PG8_STAGE(PG8_SB(0, 0), b2, voffB); PG8_STAGE(PG8_SB(0, 1), b2 + hstep, voffB); PG8_STAGE(PG8_SA(0, 0), a2, voffA);
            PG8_WAIT_V(8); PG8_WAIT_L(0); PG8_BAR; PG8_MMA(1, 0, At, B0); PG8_MMA(1, 1, At, B1); PG8_BAR; PG8_SCHED;
            PG8_LDB(B0, 1, 0); PG8_LDB(B1, 1, 1); PG8_SCHED; PG8_LDA(At, 1, 0); PG8_STAGE(PG8_SA(0, 1), a2 + hstep, voffA);
            PG8_WAIT_V(8); PG8_WAIT_L(0); PG8_BAR; PG8_MMA(0, 0, At, B0); PG8_MMA(0, 1, At, B1); PG8_BAR; PG8_SCHED;
            PG8_LDA(At, 1, 1); PG8_STAGE(PG8_SB(1, 0), b3, voffB); PG8_STAGE(PG8_SB(1, 1), b3 + hstep, voffB); PG8_STAGE(PG8_SA(1, 0), a3, voffA);
            PG8_WAIT_V(8); PG8_WAIT_L(0); PG8_BAR; PG8_MMA(1, 0, At, B0); PG8_MMA(1, 1, At, B1); PG8_BAR; PG8_SCHED;
            } else {
            PG8_LDB(B0, 0, 0); PG8_SCHED; PG8_LDA(At, 0, 0); PG8_STAGE(PG8_SA(1, 1), a1 + hstep, voffA);
            PG8_WAIT_L(8); PG8_BAR; PG8_WAIT_L(0); PG8_MMA(0, 0, At, B0); PG8_BAR; PG8_SCHED;
            PG8_LDB(B1, 0, 1); PG8_STAGE(PG8_SB(0, 0), b2, voffB);
            PG8_BAR; PG8_WAIT_L(0); PG8_MMA(0, 1, At, B1); PG8_BAR;
            PG8_LDA(At, 0, 1); PG8_STAGE(PG8_SA(0, 0), a2, voffA);
            PG8_BAR; PG8_WAIT_L(0); PG8_MMA(1, 0, At, B0); PG8_BAR; PG8_SCHED;
            PG8_STAGE(PG8_SB(0, 1), b2 + hstep, voffB);
            PG8_WAIT_V(6); PG8_BAR; PG8_MMA(1, 1, At, B1); PG8_BAR;
            PG8_LDB(B0, 1, 0); PG8_SCHED; PG8_LDA(At, 1, 0); PG8_STAGE(PG8_SA(0, 1), a2 + hstep, voffA);
            PG8_WAIT_L(8); PG8_BAR; PG8_WAIT_L(0); PG8_MMA(0, 0, At, B0); PG8_BAR; PG8_SCHED;
            PG8_LDB(B1, 1, 1); PG8_STAGE(PG8_SB(1, 0), b3, voffB);
            PG8_BAR; PG8_WAIT_L(0); PG8_MMA(0, 1, At, B1); PG8_BAR;
            PG8_LDA(At, 1, 1); PG8_STAGE(PG8_SA(1, 0), a3, voffA);
            PG8_BAR; PG8_WAIT_L(0); PG8_MMA(1, 0, At, B0); PG8_BAR; PG8_SCHED;
            PG8_STAGE(PG8_SB(1, 1), b3 + hstep, voffB);
            PG8_WAIT_V(6); PG8_BAR; PG8_MMA(1, 1, At, B1); PG8_BAR;
            }
        }
        if constexpr (ALIGN_EPI) { if (wr == 0) PG8_BAR; }
        if constexpr (!Epi::AFTER_DRAIN) { E(acc, cur, wr, wc, fr, fq); S.done(cur); }
        if (!has_next) break;
#pragma unroll
        for (int a = 0; a < 2; ++a)
#pragma unroll
            for (int b = 0; b < 2; ++b)
#pragma unroll
                for (int m = 0; m < 4; ++m)
#pragma unroll
                    for (int n = 0; n < 2; ++n) acc[a][b][m][n] = (f32x4){0.f, 0.f, 0.f, 0.f};
        cur = nxt; cA = nA; cB = nB; ++ui;
        if constexpr (ALIGN_EPI) { if (wr == 1) PG8_BAR; }
    }
    PG8_WAIT_V(0);
    if constexpr (!ALIGN_EPI) { if (wr == 0) PG8_BAR; }
    PG8_BAR;
    if constexpr (Epi::AFTER_DRAIN) { E.fused(acc, cur, wr, wc, fr, fq, lds, wid, lane); S.done(cur); }
#undef PG8_SA
#undef PG8_SB
#undef PG8_STAGE
#undef PG8_LDA
#undef PG8_LDB
#undef PG8_MMA
#undef PG8_WAIT_V
#undef PG8_WAIT_L
#undef PG8_BAR
#undef PG8_SCHED
}
}

using pg8::bf16_t; using pg8::bf16x8; using pg8::f32x4;
typedef unsigned u32x4 __attribute__((ext_vector_type(4)));
typedef unsigned u32x2 __attribute__((ext_vector_type(2)));
typedef short s16x4 __attribute__((ext_vector_type(4)));

constexpr int NB = 8, SEQ = 2048, CTX = 256, T = CTX + SEQ, D = 1024, M = NB * T, DEPTH = 4, DFF = 2816, PC = 2816;
constexpr int NCH = T / 64;
constexpr float EPS = 1e-6f;
constexpr int OFF_Z = 1536, OFF_A = 2048, OFF_B = 2056, OFF_CQ = 2064, OFF_CKV = 2448, OFF_KR = 2704, IN_COLS = 2736;
constexpr float QSCALE = 0.10206207261596575f * 1.4426950408889634f;
constexpr int NPHASE = 2 + 12 * DEPTH;
constexpr int LDS_BYTES = 155648;

constexpr size_t al256(size_t x) { return (x + 255) & ~(size_t)255; }
constexpr size_t WS_MOD = 0;
constexpr size_t WS_ROPE = al256(WS_MOD + (size_t)DEPTH * 9 * 9216 * 4);
constexpr size_t WS_X = al256(WS_ROPE + (size_t)2 * SEQ * 16 * 4);
constexpr size_t WS_H = al256(WS_X + (size_t)M * D * 4);
constexpr size_t WS_WT = al256(WS_H + (size_t)M * D * 2);
constexpr size_t WT_GU0 = 0, WT_GU1 = WT_GU0 + (size_t)2 * DFF * D * 2, WT_DN0 = WT_GU1 + (size_t)2 * DFF * D * 2, WT_DN1 = WT_DN0 + (size_t)D * DFF * 2,
                 WT_WIN = WT_DN1 + (size_t)D * DFF * 2, WT_WUQ = WT_WIN + (size_t)PC * D * 2, WT_WK = WT_WUQ + (size_t)768 * 384 * 2, WT_WV = WT_WK + (size_t)512 * 256 * 2,
                 WT_WOUT = WT_WV + (size_t)512 * 256 * 2, WT_END = WT_WOUT + (size_t)D * D * 2;
constexpr size_t WS_P = al256(WS_WT + WT_END);
constexpr size_t WS_Y = WS_P;
constexpr size_t WS_G = al256(WS_P + (size_t)M * PC * 2);
constexpr size_t NCI = (size_t)2 * NB * 4 * NCH;
constexpr size_t G_NW = 0, G_U0 = G_NW + NCI * 8192 * 2, G_QK = G_U0 + NCI * 8192 * 2, G_GG = G_QK + NCI * 4096 * 2, G_QN = G_GG + NCI * 64 * 4,
                 G_KT = G_QN + (size_t)NB * 4 * T * 128 * 2, G_END = G_KT + (size_t)NB * 4 * T * 128 * 2;
constexpr size_t WS_ACT = WS_G;
static_assert(G_END >= (size_t)M * PC * 2, "ACT fits in the GDN region");
constexpr size_t WS_O = al256(WS_G + G_END);
constexpr size_t WS_MLA = al256(WS_O + (size_t)2 * M * 512 * 4);
constexpr size_t A_CQN = 0, A_CKVN = A_CQN + (size_t)M * 384 * 2, A_Q = A_CKVN + (size_t)M * 256 * 2, A_K = A_Q + (size_t)M * 768 * 2, A_VT = A_K + (size_t)M * 768 * 2,
                 A_END = A_VT + (size_t)512 * M * 2;
constexpr size_t WS_BAR = al256(WS_MLA + A_END);
constexpr size_t WS_CNT = WS_BAR + 16384;
constexpr size_t WS_XCH = WS_CNT + 4096;
constexpr size_t WS_END = WS_XCH + (size_t)72 * 4 * 256 * 16;
static_assert(WS_END <= (size_t)603979776, "workspace map must fit 4x the largest input");

struct Args { const float* in[21]; float* out; unsigned char* ws; int ph_lo, ph_hi, coop, pad; };

__device__ __forceinline__ int otid() { int t = threadIdx.x; asm volatile("" : "+v"(t)); return t; }
__device__ __forceinline__ unsigned f2bf(float f) { unsigned u = __float_as_uint(f); return (u + 0x7fffu + ((u >> 16) & 1u)) >> 16; }
typedef float f32x2_t __attribute__((ext_vector_type(2))); typedef __bf16 bf16x2_t __attribute__((ext_vector_type(2)));
__device__ __forceinline__ unsigned pk2(float lo, float hi) { f32x2_t v = {lo, hi}; bf16x2_t b = __builtin_convertvector(v, bf16x2_t); return __builtin_bit_cast(unsigned, b); }
__device__ __forceinline__ float bf2f(unsigned short v) { return __uint_as_float((unsigned)v << 16); }
__device__ __forceinline__ float bflo(unsigned w) { return __uint_as_float(w << 16); }
__device__ __forceinline__ float bfhi(unsigned w) { return __uint_as_float(w & 0xffff0000u); }
__device__ __forceinline__ float wave_sum(float v) {
#pragma unroll
    for (int o = 32; o >= 1; o >>= 1) v += __shfl_xor(v, o);
    return v;
}
__device__ __forceinline__ float xmax16(float v) { const unsigned u = __float_as_uint(v); const auto r = __builtin_amdgcn_permlane16_swap(u, u, false, false); return fmaxf(__uint_as_float(r[0]), __uint_as_float(r[1])); }
__device__ __forceinline__ float xmax32(float v) { const unsigned u = __float_as_uint(v); const auto r = __builtin_amdgcn_permlane32_swap(u, u, false, false); return fmaxf(__uint_as_float(r[0]), __uint_as_float(r[1])); }
__device__ __forceinline__ float xsum16(float v) { const unsigned u = __float_as_uint(v); const auto r = __builtin_amdgcn_permlane16_swap(u, u, false, false); return __uint_as_float(r[0]) + __uint_as_float(r[1]); }
__device__ __forceinline__ float xsum32(float v) { const unsigned u = __float_as_uint(v); const auto r = __builtin_amdgcn_permlane32_swap(u, u, false, false); return __uint_as_float(r[0]) + __uint_as_float(r[1]); }
__device__ __forceinline__ float silu_f(float v) { return v * __builtin_amdgcn_rcpf(1.0f + __builtin_amdgcn_exp2f(-1.4426950408889634f * v)); }
__device__ __forceinline__ f32x4 mfma16(bf16x8 a, bf16x8 b, f32x4 c) { return __builtin_amdgcn_mfma_f32_16x16x32_bf16(a, b, c, 0, 0, 0); }

#define LAS __attribute__((address_space(3)))
#define XB_TMO      128
#define XB_XCNT(j)  (256  + 64 * (j))
#define XB_XSUB(j)  (1280 + 64 * (j))
#define XB_XGEN(j)  (2304 + 64 * (j))
#define XB_TOP      3328
#define XB_TOPGEN   3392
#define XCD_BAR_WORDS 3456
#define XB_SPIN_CAP (1u << 18)

__device__ __forceinline__ unsigned xb_ld(unsigned* p)              { return __hip_atomic_load(p, __ATOMIC_RELAXED, __HIP_MEMORY_SCOPE_AGENT); }
__device__ __forceinline__ unsigned xb_add(unsigned* p, unsigned v) { return __hip_atomic_fetch_add(p, v, __ATOMIC_RELAXED, __HIP_MEMORY_SCOPE_AGENT); }
__device__ __forceinline__ unsigned xb_xcc_id() { return (unsigned)__builtin_amdgcn_s_getreg((3 << 11) | 20) & 0xFu; }
#define XB_SPIN(cond, bar) do { unsigned _sp = 0; while (cond) { __builtin_amdgcn_s_sleep(1); \
    if ((++_sp & 255u) == 0u) { if (xb_ld(&(bar)[XB_TMO])) break; if (_sp > XB_SPIN_CAP) { atomicAdd(&(bar)[XB_TMO], 1u); break; } } } } while (0)

struct XcdBarrier {
    unsigned* bar; unsigned x;
    volatile LAS unsigned* st;
};

__device__ __forceinline__ XcdBarrier xcd_barrier_post(unsigned* bar, volatile LAS unsigned* st) {
    XcdBarrier b; b.bar = bar; b.x = xb_xcc_id(); b.st = st;
    if (threadIdx.x == 0) (void)xb_add(&bar[XB_XCNT(b.x)], 1u);
    return b;
}
__device__ __forceinline__ void xcd_barrier_complete(unsigned* bar, unsigned x, unsigned& nloc, unsigned& nx) {
    const unsigned G = gridDim.x * gridDim.y * gridDim.z;
    unsigned sum, cnt, mine, sp = 0u;
    for (;;) {
        sum = 0u; cnt = 0u; mine = 0u;
#pragma unroll
        for (unsigned j = 0; j < 16; ++j) { const unsigned c = xb_ld(&bar[XB_XCNT(j)]); sum += c; cnt += (c > 0u) ? 1u : 0u; mine = (j == x) ? c : mine; }
        if (sum == G) break;
        __builtin_amdgcn_s_sleep(1);
        if ((++sp & 255u) == 0u) { if (xb_ld(&bar[XB_TMO])) break; if (sp > XB_SPIN_CAP) { atomicAdd(&bar[XB_TMO], 1u); break; } }
    }
    nloc = mine > 0u ? mine : 1u; nx = cnt > 0u ? cnt : 1u;
}

__device__ __forceinline__ void xcd_barrier(const XcdBarrier& b) {
    asm volatile("s_waitcnt vmcnt(0)" ::: "memory");
    __syncthreads();
    if (threadIdx.x == 0) {
        unsigned* bar = b.bar;
        __builtin_amdgcn_s_waitcnt(0);
        unsigned nloc = b.st[0], nx = b.st[1];
        if (nloc == 0u) { xcd_barrier_complete(bar, b.x, nloc, nx); b.st[0] = nloc; b.st[1] = nx; }
        const unsigned old = xb_add(&bar[XB_XSUB(b.x)], 1u);
        const unsigned gen = old / nloc;
        if (old + 1u == (gen + 1u) * nloc) {
            __builtin_amdgcn_fence(__ATOMIC_RELEASE, "agent");
            asm volatile("s_waitcnt vmcnt(0)" ::: "memory");
            const unsigned og = xb_add(&bar[XB_TOP], 1u);
            const unsigned tg = og / nx;
            if (og + 1u == (tg + 1u) * nx) xb_add(&bar[XB_TOPGEN], 1u);
            else XB_SPIN(xb_ld(&bar[XB_TOPGEN]) == tg, bar);
            __builtin_amdgcn_fence(__ATOMIC_ACQUIRE, "agent");
            xb_add(&bar[XB_XGEN(b.x)], 1u);
            asm volatile("s_waitcnt vmcnt(0)" ::: "memory");
        } else {
            XB_SPIN(xb_ld(&bar[XB_XGEN(b.x)]) == gen, bar);
            __builtin_amdgcn_fence(__ATOMIC_ACQUIRE, "agent");
            asm volatile("s_waitcnt vmcnt(0)" ::: "memory");
        }
    }
    __syncthreads();
}

typedef const f32x4 (&AccRef)[2][2][4][2];
__device__ __forceinline__ u32x4 pack8(const f32x4& a, const f32x4& b) { u32x4 w; w.x = pk2(a[0], a[1]); w.y = pk2(a[2], a[3]); w.z = pk2(b[0], b[1]); w.w = pk2(b[2], b[3]); return w; }
struct EpiGU {
    static constexpr bool PERM = true, AFTER_DRAIN = false;
    bf16_t* O; int ldo;
    __device__ __forceinline__ void operator()(AccRef acc, const pg8::Unit& u, int wr, int wc, int fr, int fq) const {
#pragma unroll
        for (int ai = 0; ai < 2; ++ai)
#pragma unroll
            for (int m = 0; m < 4; ++m) {
                const int row = u.pm * 256 + ai * 128 + wr * 64 + m * 16 + fr;
                const int col = u.pn * 128 + wc * 32 + fq * 8;
                f32x4 v0, v1;
#pragma unroll
                for (int j = 0; j < 4; ++j) { v0[j] = silu_f(acc[ai][0][m][0][j]) * acc[ai][1][m][0][j]; v1[j] = silu_f(acc[ai][0][m][1][j]) * acc[ai][1][m][1][j]; }
                *(u32x4*)(O + (size_t)row * ldo + col) = pack8(v0, v1);
            }
    }
};
struct EpiF32 {
    static constexpr bool PERM = true, AFTER_DRAIN = false;
    float* O; int ldo;
    __device__ __forceinline__ void operator()(AccRef acc, const pg8::Unit& u, int wr, int wc, int fr, int fq) const {
#pragma unroll
        for (int ai = 0; ai < 2; ++ai)
#pragma unroll
            for (int m = 0; m < 4; ++m) {
                const int row = u.pm * 256 + ai * 128 + wr * 64 + m * 16 + fr;
#pragma unroll
                for (int bj = 0; bj < 2; ++bj) {
                    const int col = u.pn * 256 + bj * 128 + wc * 32 + fq * 8;
                    float* p = O + (size_t)row * ldo + col;
                    *(f32x4*)p = acc[ai][bj][m][0]; *(f32x4*)(p + 4) = acc[ai][bj][m][1];
                }
            }
    }
};
struct EpiBf16 {
    static constexpr bool PERM = true, AFTER_DRAIN = false;
    bf16_t* O; int ldo;
    __device__ __forceinline__ void operator()(AccRef acc, const pg8::Unit& u, int wr, int wc, int fr, int fq) const {
#pragma unroll
        for (int ai = 0; ai < 2; ++ai)
#pragma unroll
            for (int m = 0; m < 4; ++m) {
                const int row = u.pm * 256 + ai * 128 + wr * 64 + m * 16 + fr;
#pragma unroll
                for (int bj = 0; bj < 2; ++bj) {
                    const int col = u.pn * 256 + bj * 128 + wc * 32 + fq * 8;
                    *(u32x4*)(O + (size_t)row * ldo + col) = pack8(acc[ai][bj][m][0], acc[ai][bj][m][1]);
                }
            }
    }
};
struct EpiQ {
    static constexpr bool PERM = false, AFTER_DRAIN = false;
    bf16_t* Q; const float* rc; const float* rs;
    __device__ __forceinline__ void operator()(AccRef acc, const pg8::Unit& u, int wr, int wc, int fr, int fq) const {
#pragma unroll
        for (int ai = 0; ai < 2; ++ai)
#pragma unroll
            for (int m = 0; m < 4; ++m) {
                const int row = u.pm * 256 + ai * 128 + wr * 64 + m * 16 + fr;
                const int b = row / T, t = row - b * T;
#pragma unroll
                for (int bj = 0; bj < 2; ++bj) {
                    const int g32 = u.pn * 8 + bj * 4 + wc, head = g32 / 3, part = g32 - head * 3;
                    bf16_t* base = Q + ((size_t)(b * 8 + head) * T + t) * 96;
                    f32x4 x1 = acc[ai][bj][m][0], x2 = acc[ai][bj][m][1];
                    int d0;
                    if (part < 2) { d0 = part * 32 + fq * 4; }
                    else {
                        d0 = 64 + fq * 4;
                        if (t >= CTX) {
                            const int s = t - CTX;
                            const f32x4 cs = *(const f32x4*)(rc + s * 16 + fq * 4), sn = *(const f32x4*)(rs + s * 16 + fq * 4);
                            const f32x4 o1 = x1 * cs - x2 * sn, o2 = x2 * cs + x1 * sn; x1 = o1; x2 = o2;
                        }
                    }
                    x1 = x1 * QSCALE; x2 = x2 * QSCALE;
                    u32x2 w1, w2; w1.x = pk2(x1[0], x1[1]); w1.y = pk2(x1[2], x1[3]); w2.x = pk2(x2[0], x2[1]); w2.y = pk2(x2[2], x2[3]);
                    *(u32x2*)(base + d0) = w1; *(u32x2*)(base + d0 + 16) = w2;
                }
            }
    }
};
struct EpiK {
    static constexpr bool PERM = true, AFTER_DRAIN = false;
    bf16_t* K;
    __device__ __forceinline__ void operator()(AccRef acc, const pg8::Unit& u, int wr, int wc, int fr, int fq) const {
#pragma unroll
        for (int ai = 0; ai < 2; ++ai)
#pragma unroll
            for (int m = 0; m < 4; ++m) {
                const int row = u.pm * 256 + ai * 128 + wr * 64 + m * 16 + fr;
                const int b = row / T, t = row - b * T;
#pragma unroll
                for (int bj = 0; bj < 2; ++bj) {
                    const int col = u.pn * 256 + bj * 128 + wc * 32 + fq * 8, head = col >> 6, d = col & 63;
                    *(u32x4*)(K + ((size_t)(b * 8 + head) * T + t) * 96 + d) = pack8(acc[ai][bj][m][0], acc[ai][bj][m][1]);
                }
            }
    }
};

struct PanelOrder {
    int c, latent_only;
    __device__ __forceinline__ bool next(int i, pg8::Unit& u) const {
        const int x = c & 7, kq = c >> 3;
        if (i == 0) { const int p = (kq >> 2) * 8 + x; u.pm = latent_only ? (p >> 3) * 9 + 1 + (p & 7) : p; u.pn = kq & 3; return true; }
        if (i == 1 && !latent_only && c < 32) { u.pm = 64 + x; u.pn = kq; return true; }
        return false;
    }
    __device__ __forceinline__ void a_ready(const pg8::Unit&) const {}
    __device__ __forceinline__ void done(const pg8::Unit&) const {}
};
constexpr int EX_RED = 131072, EX_FIN = EX_RED + 4 * 256 * 16;
static_assert(EX_FIN + 256 * 8 <= LDS_BYTES - 16, "exchange scratch fits");
struct EpiResNorm {
    static constexpr bool PERM = true, AFTER_DRAIN = false;
    float* X; bf16_t* H; float* out;
    const float* gate_base; const float* gpost; float post_w;
    const float* shift_base; const float* gpre;
    float* slots; unsigned* cnt; unsigned char* lds;
    __device__ __forceinline__ void operator()(AccRef acc, const pg8::Unit& u, int wr, int wc, int fr_, int fq_) const {
        int fr = fr_, fq = fq_; asm volatile("" : "+v"(fr), "+v"(fq));
        const int mr = (u.pm % 9 == 0) ? 8 : u.pm / 9;
        const float* gate = gate_base + (size_t)mr * 9216;
        float* red = (float*)(lds + EX_RED); float* fin = (float*)(lds + EX_FIN);
        const int colb = u.pn * 256 + wc * 32 + fq * 8, tid = (wr * 4 + wc) * 64 + fq * 16 + fr;
        f32x4 av[2][2];
#pragma unroll
        for (int bj = 0; bj < 2; ++bj)
#pragma unroll
            for (int n = 0; n < 2; ++n) { const int c = colb + bj * 128 + n * 4; av[bj][n] = (*(const f32x4*)(gate + c)) * (*(const f32x4*)(gpost + c)) * post_w; }
#pragma unroll
        for (int ai = 0; ai < 2; ++ai)
#pragma unroll
            for (int m = 0; m < 4; ++m) {
                const int lrow = ai * 128 + wr * 64 + m * 16 + fr; const size_t row = (size_t)u.pm * 256 + lrow;
                float s1 = 0.f, s2 = 0.f, s3 = 0.f, s4 = 0.f;
                int colv = colb; asm volatile("" : "+v"(colv));
#pragma unroll
                for (int bj = 0; bj < 2; ++bj)
#pragma unroll
                    for (int n = 0; n < 2; ++n) {
                        const int c = colv + bj * 128 + n * 4;
                        const f32x4 y = acc[ai][bj][m][n], x = *(const f32x4*)(X + row * 1024 + c);
                        const f32x4 ay = av[bj][n] * y;
#pragma unroll
                        for (int j = 0; j < 4; ++j) { s1 += y[j] * y[j]; s2 += x[j] * x[j]; s3 += x[j] * ay[j]; s4 += ay[j] * ay[j]; }
                    }
                s1 = xsum32(xsum16(s1)); s2 = xsum32(xsum16(s2)); s3 = xsum32(xsum16(s3)); s4 = xsum32(xsum16(s4));
                if (fq == 0) *(f32x4*)(red + (wc * 256 + lrow) * 4) = (f32x4){s1, s2, s3, s4};
            }
        __syncthreads();
#pragma unroll 1
        for (int rex = 0; rex < 1 + ((PROBE_MASK >> 22) & 1); ++rex) {
        if (tid < 256) {
            f32x4 t = *(const f32x4*)(red + tid * 4);
#pragma unroll
            for (int w = 1; w < 4; ++w) t = t + *(const f32x4*)(red + (w * 256 + tid) * 4);
            float* sl = slots + ((size_t)(u.pm * 4 + u.pn) * 256 + tid) * 4;
#pragma unroll
            for (int q = 0; q < 4; ++q) __hip_atomic_store(sl + q, t[q], __ATOMIC_RELAXED, __HIP_MEMORY_SCOPE_AGENT);
        }
        asm volatile("s_waitcnt vmcnt(0)" ::: "memory");
        __syncthreads();
        if (tid == 0) {
            __hip_atomic_fetch_add(cnt + u.pm, 1u, __ATOMIC_RELAXED, __HIP_MEMORY_SCOPE_AGENT);
            unsigned sp = 0;
            while (__hip_atomic_load(cnt + u.pm, __ATOMIC_RELAXED, __HIP_MEMORY_SCOPE_AGENT) < 4u * (rex + 1)) { __builtin_amdgcn_s_sleep(1); if (++sp > (1u << 20)) break; }
        }
        __syncthreads();
        if (tid < 256) {
            float t[4] = {0.f, 0.f, 0.f, 0.f};
#pragma unroll
            for (int pn2 = 0; pn2 < 4; ++pn2)
#pragma unroll
                for (int q = 0; q < 4; ++q) t[q] += __hip_atomic_load(slots + ((size_t)(u.pm * 4 + pn2) * 256 + tid) * 4 + q, __ATOMIC_RELAXED, __HIP_MEMORY_SCOPE_AGENT);
            const float ry = rsqrtf(t[0] * (1.0f / 1024.0f) + EPS);
            const float ssx = t[1] + 2.0f * ry * t[2] + ry * ry * t[3];
            fin[tid * 2] = ry; fin[tid * 2 + 1] = rsqrtf(fmaxf(ssx, 0.f) * (1.0f / 1024.0f) + EPS);
        }
        __syncthreads();
        }
        const float* shift = shift_base + (size_t)mr * 9216; const float* scale = shift + 1024;
        f32x4 g2[2][2], sh[2][2];
#pragma unroll
        for (int bj = 0; bj < 2; ++bj)
#pragma unroll
            for (int n = 0; n < 2; ++n) {
                const int c = colb + bj * 128 + n * 4;
                if (!out) { g2[bj][n] = (*(const f32x4*)(gpre + c)) * (*(const f32x4*)(scale + c) + 1.0f); sh[bj][n] = *(const f32x4*)(shift + c); }
                else { g2[bj][n] = (f32x4){0.f, 0.f, 0.f, 0.f}; sh[bj][n] = g2[bj][n]; }
            }
#pragma unroll
        for (int ai = 0; ai < 2; ++ai)
#pragma unroll
            for (int m = 0; m < 4; ++m) {
                const int lrow = ai * 128 + wr * 64 + m * 16 + fr; const size_t row = (size_t)u.pm * 256 + lrow;
                const float ry = fin[lrow * 2], rx = fin[lrow * 2 + 1];
                const int b = u.pm / 9, t = (u.pm - b * 9) * 256 + lrow;
                int colv = colb; asm volatile("" : "+v"(colv));
#pragma unroll
                for (int bj = 0; bj < 2; ++bj) {
                    f32x4 hv[2];
#pragma unroll
                    for (int n = 0; n < 2; ++n) {
                        const int c = colv + bj * 128 + n * 4;
                        const f32x4 y = acc[ai][bj][m][n], x = *(const f32x4*)(X + row * 1024 + c);
                        const f32x4 xn = x + av[bj][n] * y * ry;
                        if (out) { if (t >= CTX) *(f32x4*)(out + ((size_t)b * SEQ + (t - CTX)) * 1024 + c) = xn; }
                        else {
                            *(f32x4*)(X + row * 1024 + c) = xn;
                            hv[n] = (xn * rx) * g2[bj][n] + sh[bj][n];
                        }
                    }
                    if (!out) *(u32x4*)(H + row * 1024 + colv + bj * 128) = pack8(hv[0], hv[1]);
                }
            }
        __syncthreads();
    }
};

struct Ctx {
    const float* const* in; unsigned char* ws; float* out;
};
#define WSP(T_, off) ((T_*)(a.ws + (off)))

__device__ __forceinline__ void phase_mod(const Args& a, unsigned char* lds) {
    const int tid = otid();
    float* sl = (float*)lds;
    float* red = sl + 9 * 1024;
    const float* cvec = a.in[1]; const float* cctx = a.in[3];
    for (int i = tid; i < 9 * 1024; i += 512) { const int r = i >> 10, k = i & 1023; const float v = r < 8 ? cvec[r * 1024 + k] : cctx[k]; sl[i] = v / (1.0f + expf(-v)); }
    __syncthreads();
    const float* wada = a.in[4]; const float* bada = a.in[5];
    float* mod = WSP(float, WS_MOD);
    const int c4 = (tid & 15) * 4, kg = tid >> 4;
    for (int item = blockIdx.x; item < DEPTH * 144; item += gridDim.x) {
        const int l = item / 144, j0 = (item - l * 144) * 64;
        f32x4 acc[9];
#pragma unroll
        for (int r = 0; r < 9; ++r) acc[r] = (f32x4){0.f, 0.f, 0.f, 0.f};
        const float* w = wada + ((size_t)l * 1024 + kg * 32) * 9216 + j0 + c4;
        const float* s = sl + kg * 32;
#pragma unroll 16
        for (int kk = 0; kk < 32; ++kk) {
            const f32x4 wv = *(const f32x4*)(w + (size_t)kk * 9216);
#pragma unroll
            for (int r = 0; r < 9; ++r) acc[r] = acc[r] + wv * s[r * 1024 + kk];
        }
#pragma unroll
        for (int r = 0; r < 9; ++r) *(f32x4*)(red + (kg * 9 + r) * 64 + c4) = acc[r];
        __syncthreads();
        for (int i = tid; i < 576; i += 512) {
            const int r = i >> 6, cc = i & 63; float v = 0.f;
#pragma unroll
            for (int g = 0; g < 32; ++g) v += red[(g * 9 + r) * 64 + cc];
            mod[((size_t)l * 9 + r) * 9216 + j0 + cc] = v + bada[l * 9216 + j0 + cc];
        }
        __syncthreads();
    }
    float* rc = WSP(float, WS_ROPE); float* rs = rc + SEQ * 16;
    for (int i = blockIdx.x * 512 + tid; i < SEQ * 16; i += gridDim.x * 512) {
        const int s = i >> 4, k = i & 15, pos = (k < 8) ? (s >> 6) : (s & 63), j = k & 7;
        const float invf = exp2f(-(float)j * 0.125f * 13.287712379549449f);
        const float ang = (float)pos * invf;
        rc[i] = __cosf(ang); rs[i] = __sinf(ang);
    }
}

__device__ __forceinline__ void transpose_item(const float* src, int ld, int K, int col0, int ncols, bf16_t* dst, int dst_row0, int mode, unsigned char* lds) {
    float* tile = (float*)lds;
    const int tid = otid();
    const int kr = tid >> 4, c4 = (tid & 15) * 4;
    const int n = tid >> 3, k8 = (tid & 7) * 8;
    const int c = col0 + n;
    int drow;
    if (mode == 0) drow = dst_row0 + n; else drow = (c >> 7) * 256 + (c & 127) + (mode == 2 ? 128 : 0);
    for (int k0 = 0; k0 < K; k0 += 64) {
#pragma unroll
        for (int rr = 0; rr < 2; ++rr) {
            const int k = kr + 32 * rr, col = col0 + c4;
            f32x4 v = {0.f, 0.f, 0.f, 0.f};
            if (col < ncols) v = *(const f32x4*)(src + (size_t)(k0 + k) * ld + col);
            float* tp = tile + k * 65 + c4; tp[0] = v[0]; tp[1] = v[1]; tp[2] = v[2]; tp[3] = v[3];
        }
        __syncthreads();
        float f[8];
#pragma unroll
        for (int i = 0; i < 8; ++i) f[i] = tile[(k8 + i) * 65 + n];
        u32x4 w; w.x = pk2(f[0], f[1]); w.y = pk2(f[2], f[3]); w.z = pk2(f[4], f[5]); w.w = pk2(f[6], f[7]);
        *(u32x4*)(dst + (size_t)drow * K + k0 + k8) = w;
        __syncthreads();
    }
}
__device__ __forceinline__ void phase_transpose(const Args& a, int l, unsigned char* lds, int item_lo, int item_hi, int wg_first) {
    unsigned char* wt = a.ws + WS_WT;
    if ((int)blockIdx.x < wg_first) return;
    for (int item = item_lo + ((int)blockIdx.x - wg_first); item < item_hi; item += (int)gridDim.x - wg_first) {
        if (item < 176) {
            const int job = item / 44, tl = item - job * 44, f = job >> 1, up = job & 1;
            const float* src = (up ? a.in[9] : a.in[8]) + (size_t)(l * 2 + f) * D * DFF;
            transpose_item(src, DFF, D, tl * 64, DFF, (bf16_t*)(wt + (f ? WT_GU1 : WT_GU0)), 0, up ? 2 : 1, lds);
        } else if (item < 208) {
            const int it = item - 176, f = it >> 4, tl = it & 15;
            transpose_item(a.in[10] + (size_t)(l * 2 + f) * DFF * D, D, DFF, tl * 64, D, (bf16_t*)(wt + (f ? WT_DN1 : WT_DN0)), tl * 64, 0, lds);
        } else if (item < 252) {
            const int tl = item - 208;
            transpose_item(a.in[11] + (size_t)l * D * IN_COLS, IN_COLS, D, tl * 64, IN_COLS, (bf16_t*)(wt + WT_WIN), tl * 64, 0, lds);
        } else if (item < 264) {
            const int tl = item - 252;
            transpose_item(a.in[18] + (size_t)l * 384 * 768, 768, 384, tl * 64, 768, (bf16_t*)(wt + WT_WUQ), tl * 64, 0, lds);
        } else if (item < 280) {
            const int it = item - 264, v = it >> 3, hh = it & 7;
            transpose_item(a.in[19] + (size_t)l * 256 * 1024, 1024, 256, hh * 128 + v * 64, 1024, (bf16_t*)(wt + (v ? WT_WV : WT_WK)), hh * 64, 0, lds);
        } else {
            const int tl = item - 280;
            transpose_item(a.in[20] + (size_t)l * D * D, D, D, tl * 64, D, (bf16_t*)(wt + WT_WOUT), tl * 64, 0, lds);
        }
    }
}

struct RowCfg { int first, has_post, post_l, post_slot, has_pre, pre_l, pre_slot, final_; float post_w; };
__device__ __forceinline__ void phase_rowpass(const Args& a, const RowCfg& c) {
    const int tid = otid(), lane = tid & 63, wv = tid >> 6;
    float* X = WSP(float, WS_X); const float* Y = WSP(float, WS_Y); bf16_t* H = WSP(bf16_t, WS_H);
    const float* mod = WSP(float, WS_MOD);
    const float* gpost = a.in[7] + (size_t)(c.post_l * 3 + c.post_slot) * D;
    const float* gpre = a.in[6] + (size_t)(c.pre_l * 3 + c.pre_slot) * D;
    for (int m = blockIdx.x * 8 + wv; m < M; m += gridDim.x * 8) {
        const int b = m / T, t = m - b * T, mr = (t < CTX) ? 8 : b;
        const float* src = c.first ? ((t < CTX) ? a.in[2] + ((size_t)b * CTX + t) * D : a.in[0] + ((size_t)b * SEQ + (t - CTX)) * D) : X + (size_t)m * D;
        f32x4 xv[4];
#pragma unroll
        for (int i = 0; i < 4; ++i) xv[i] = *(const f32x4*)(src + i * 256 + lane * 4);
        if (c.has_post) {
            f32x4 yv[4]; float ss = 0.f;
#pragma unroll
            for (int i = 0; i < 4; ++i) { yv[i] = *(const f32x4*)(Y + (size_t)m * D + i * 256 + lane * 4); ss += yv[i][0] * yv[i][0] + yv[i][1] * yv[i][1] + yv[i][2] * yv[i][2] + yv[i][3] * yv[i][3]; }
            ss = wave_sum(ss);
            const float r = rsqrtf(ss * (1.0f / 1024.0f) + EPS) * c.post_w;
            const float* gate = mod + ((size_t)(c.post_l * 9 + mr) * 9 + 3 * c.post_slot + 2) * D;
#pragma unroll
            for (int i = 0; i < 4; ++i) {
                const f32x4 gt = *(const f32x4*)(gate + i * 256 + lane * 4), gp = *(const f32x4*)(gpost + i * 256 + lane * 4);
                xv[i] = xv[i] + gt * (yv[i] * gp) * r;
            }
        }
        if (c.final_) {
            if (t >= CTX) {
                float* o = a.out + ((size_t)b * SEQ + (t - CTX)) * D;
#pragma unroll
                for (int i = 0; i < 4; ++i) *(f32x4*)(o + i * 256 + lane * 4) = xv[i];
            }
            continue;
        }
#pragma unroll
        for (int i = 0; i < 4; ++i) *(f32x4*)(X + (size_t)m * D + i * 256 + lane * 4) = xv[i];
        if (c.has_pre) {
            float ss = 0.f;
#pragma unroll
            for (int i = 0; i < 4; ++i) ss += xv[i][0] * xv[i][0] + xv[i][1] * xv[i][1] + xv[i][2] * xv[i][2] + xv[i][3] * xv[i][3];
            ss = wave_sum(ss);
            const float r = rsqrtf(ss * (1.0f / 1024.0f) + EPS);
            const float* shift = mod + ((size_t)(c.pre_l * 9 + mr) * 9 + 3 * c.pre_slot) * D; const float* scale = shift + D;
#pragma unroll
            for (int i = 0; i < 4; ++i) {
                const f32x4 sh = *(const f32x4*)(shift + i * 256 + lane * 4), sc = *(const f32x4*)(scale + i * 256 + lane * 4), gp = *(const f32x4*)(gpre + i * 256 + lane * 4);
                const f32x4 hv = (xv[i] * r * gp) * (sc + 1.0f) + sh;
                u32x2 w; w.x = pk2(hv[0], hv[1]); w.y = pk2(hv[2], hv[3]);
                *(u32x2*)(H + (size_t)m * D + i * 256 + lane * 4) = w;
            }
        }
    }
}

constexpr int C_RAW = 0, C_QN = 52224, C_KN = C_QN + 64 * 136 * 2, C_V = C_KN + 64 * 136 * 2, C_GS = C_V + 64 * 128 * 2, C_TMP = C_GS + 1536, C_ENDB = C_TMP + 64 * 128 * 4;
constexpr int C_KK = 0, C_QKR = 16384, C_AS = 32768;
static_assert(C_AS + 32768 <= C_KN && C_ENDB <= LDS_BYTES, "chunk LDS map");

__device__ __forceinline__ void chunk_item(const Args& a, int l, int item, unsigned char* lds) {
    const int tid = otid(), lane = tid & 63, wv = tid >> 6, quad = lane >> 4, l15 = lane & 15;
    const int n = item % NCH, h = (item / NCH) & 3, b = item / (NCH * 4);
    const int t0 = n * 64, seg_lo = (n < 4) ? 0 : CTX, seg_hi = (n < 4) ? CTX : T;
    const bf16_t* P = WSP(const bf16_t, WS_P);
    bf16_t* RAW = (bf16_t*)(lds + C_RAW); bf16_t* QNs = (bf16_t*)(lds + C_QN); bf16_t* KNs = (bf16_t*)(lds + C_KN); bf16_t* Vs = (bf16_t*)(lds + C_V);
    float* GS = (float*)(lds + C_GS); float* BS = GS + 128; float* BE = GS + 256; float* TMP = (float*)(lds + C_TMP);
    float* KK = (float*)(lds + C_KK); float* QKR = (float*)(lds + C_QKR); float* AS = (float*)(lds + C_AS);
    unsigned char* gb = a.ws + WS_G;
    float cwr[3][5];
    {
        const float* cw0 = a.in[12] + (size_t)l * 5 * 1536 + h * 128 + (tid & 127);
#pragma unroll
        for (int part = 0; part < 3; ++part)
#pragma unroll
            for (int j = 0; j < 5; ++j) cwr[part][j] = cw0[j * 1536 + part * 512];
    }
#pragma unroll 1
    for (int rep15 = 0; rep15 < 1 + ((PROBE_MASK >> 18) & 1); ++rep15) {
    for (int idx = tid; idx < 68 * 48; idx += 512) {
        const int rr = idx / 48, ch = idx - rr * 48, part = ch >> 4, c8 = (ch & 15) * 8, tt = t0 - 2 + rr;
        u32x4 v = {0u, 0u, 0u, 0u};
        if (tt >= seg_lo && tt < seg_hi) v = *(const u32x4*)(P + ((size_t)b * T + tt) * PC + part * 512 + h * 128 + c8);
        *(u32x4*)(RAW + rr * 384 + part * 128 + c8) = v;
    }
    if (wv < 2) {
        const int d = wv, i = lane;
        const bf16_t* pr = P + ((size_t)b * T + t0 + i) * PC;
        const float av = bf2f(pr[OFF_A + d * 4 + h]), bv = bf2f(pr[OFF_B + d * 4 + h]);
        const float alog = a.in[13][(l * 2 + d) * 4 + h], dtb = a.in[14][(l * 2 + d) * 4 + h];
        const float xs = av + dtb;
        const float sp = fmaxf(xs, 0.f) + log1pf(expf(-fabsf(xs)));
        float g = -expf(alog) * sp;
        if (d == 0) {
#pragma unroll
            for (int o = 1; o < 64; o <<= 1) { const float u = __shfl_up(g, o); if (lane >= o) g += u; }
        } else {
#pragma unroll
            for (int o = 1; o < 64; o <<= 1) { const float u = __shfl_down(g, o); if (lane + o < 64) g += u; }
        }
        const float beta = 1.0f / (1.0f + expf(-bv));
        GS[d * 64 + i] = g; BS[d * 64 + i] = beta; BE[d * 64 + i] = beta * expf(g);
        const size_t ci = ((size_t)(d * NB + b) * 4 + h) * NCH + n;
        ((float*)(gb + G_GG))[ci * 64 + i] = g;
    }
    __syncthreads();
    {
        const int c = tid & 127, rg = tid >> 7;
#pragma unroll
        for (int part = 0; part < 3; ++part) {
            float w[5];
#pragma unroll
            for (int j = 0; j < 5; ++j) w[j] = cwr[part][j];
            float win[20];
#pragma unroll
            for (int r = 0; r < 20; ++r) win[r] = bf2f(RAW[(rg * 16 + r) * 384 + part * 128 + c]);
#pragma unroll
            for (int i = 0; i < 16; ++i) {
                float s = 0.f;
#pragma unroll
                for (int j = 0; j < 5; ++j) s += w[j] * win[i + j];
                s = silu_f(s);
                if (part == 2) Vs[(rg * 16 + i) * 128 + c] = (bf16_t)f2bf(s); else TMP[(rg * 16 + i) * 128 + c] = s;
            }
            if (part < 2) {
                __syncthreads();
#pragma unroll
                for (int rr = 0; rr < 8; ++rr) {
                    const int row = wv * 8 + rr;
                    const float v0 = TMP[row * 128 + lane * 2], v1 = TMP[row * 128 + lane * 2 + 1];
                    const float ss = wave_sum(v0 * v0 + v1 * v1);
                    float r = rsqrtf(ss + EPS);
                    if (part == 0) {
                        r *= 0.08838834764831845f;
                        const unsigned w2 = pk2(v0 * r, v1 * r);
                        *(unsigned*)(QNs + row * 136 + lane * 2) = w2;
                        *(unsigned*)((bf16_t*)(gb + G_QN) + ((size_t)(b * 4 + h) * T + t0 + row) * 128 + lane * 2) = w2;
                    } else {
                        *(unsigned*)(KNs + row * 136 + lane * 2) = pk2(v0 * r, v1 * r);
                    }
                }
                __syncthreads();
            }
        }
    }
    __syncthreads();
    {
        bf16_t* KT = (bf16_t*)(gb + G_KT) + ((size_t)(b * 4 + h) * NCH + n) * 8192;
        for (int idx = tid; idx < 1024; idx += 512) {
            const int dk = idx >> 3, j8 = (idx & 7) * 8;
            unsigned short e[8];
#pragma unroll
            for (int q = 0; q < 8; ++q) e[q] = KNs[(j8 + q) * 136 + dk];
            u32x4 w; w.x = e[0] | ((unsigned)e[1] << 16); w.y = e[2] | ((unsigned)e[3] << 16); w.z = e[4] | ((unsigned)e[5] << 16); w.w = e[6] | ((unsigned)e[7] << 16);
            *(u32x4*)(KT + dk * 64 + j8) = w;
        }
        const int it = wv >> 1;
#pragma unroll
        for (int jj = 0; jj < 2; ++jj) {
            const int jt = (wv & 1) * 2 + jj;
            f32x4 ck = {0.f, 0.f, 0.f, 0.f}, cq = {0.f, 0.f, 0.f, 0.f};
#pragma unroll
            for (int ks = 0; ks < 4; ++ks) {
                const bf16x8 ka = *(const bf16x8*)(KNs + (it * 16 + l15) * 136 + ks * 32 + quad * 8);
                const bf16x8 qa = *(const bf16x8*)(QNs + (it * 16 + l15) * 136 + ks * 32 + quad * 8);
                const bf16x8 kb = *(const bf16x8*)(KNs + (jt * 16 + l15) * 136 + ks * 32 + quad * 8);
                ck = mfma16(ka, kb, ck); cq = mfma16(qa, kb, cq);
            }
#pragma unroll
            for (int r = 0; r < 4; ++r) { KK[(it * 16 + quad * 4 + r) * 64 + jt * 16 + l15] = ck[r]; QKR[(it * 16 + quad * 4 + r) * 64 + jt * 16 + l15] = cq[r]; }
        }
    }
    __syncthreads();
    for (int idx = tid; idx < 8192; idx += 512) {
        const int d = idx >> 12, i = (idx >> 6) & 63, j = idx & 63;
        const int ri = d ? 63 - i : i, rj = d ? 63 - j : j;
        const float gi = GS[d * 64 + i], gj = GS[d * 64 + j];
        const float e = (ri >= rj) ? __expf(gi - gj) : 0.f;
        AS[d * 4096 + ri * 64 + rj] = (ri > rj) ? BS[d * 64 + i] * KK[i * 64 + j] * e : 0.f;
        const size_t ci = ((size_t)(d * NB + b) * 4 + h) * NCH + n;
        ((bf16_t*)(gb + G_QK))[ci * 4096 + i * 64 + j] = (bf16_t)f2bf(QKR[i * 64 + j] * e);
    }
    __syncthreads();
    }
    bf16_t* Tm = (bf16_t*)(lds + C_KK);
    if (tid < 128) {
        const int d = tid >> 6, c = tid & 63;
        const float* As = AS + d * 4096;
        float sol[64];
#pragma unroll
        for (int r = 0; r < 64; ++r) {
            float pv[4] = {(r == c) ? 1.f : 0.f, 0.f, 0.f, 0.f};
#pragma unroll
            for (int rp = 0; rp < r; ++rp) pv[rp & 3] -= As[r * 64 + rp] * sol[rp];
            const float v = (pv[0] + pv[1]) + (pv[2] + pv[3]);
            sol[r] = v;
            Tm[d * 4608 + r * 72 + c] = (bf16_t)f2bf(v);
        }
    }
    {
        const int d = wv >> 2, cq = wv & 3;
        const size_t ci = ((size_t)(d * NB + b) * 4 + h) * NCH + n;
        bf16_t* U0 = (bf16_t*)(gb + G_U0) + ci * 8192; bf16_t* NW = (bf16_t*)(gb + G_NW) + ci * 8192;
        bf16x8 bfr[2][4];
#pragma unroll
        for (int ks = 0; ks < 2; ++ks)
#pragma unroll
            for (int ct = 0; ct < 4; ++ct) {
                const int cl = (cq & 1) * 64 + ct * 16 + l15;
                float f[8];
#pragma unroll
                for (int e = 0; e < 8; ++e) {
                    const int rp = ks * 32 + quad * 8 + e, j = d ? 63 - rp : rp;
                    f[e] = (cq < 2) ? BS[d * 64 + j] * bf2f(Vs[j * 128 + cl]) : BE[d * 64 + j] * bf2f(KNs[j * 136 + cl]);
                }
                u32x4 w; w.x = pk2(f[0], f[1]); w.y = pk2(f[2], f[3]); w.z = pk2(f[4], f[5]); w.w = pk2(f[6], f[7]);
                bfr[ks][ct] = __builtin_bit_cast(bf16x8, w);
            }
        __syncthreads();
        f32x4 acc[4][4];
#pragma unroll
        for (int it = 0; it < 4; ++it)
#pragma unroll
            for (int ct = 0; ct < 4; ++ct) acc[it][ct] = (f32x4){0.f, 0.f, 0.f, 0.f};
#pragma unroll
        for (int ks = 0; ks < 2; ++ks) {
            bf16x8 af[4];
#pragma unroll
            for (int it = 0; it < 4; ++it) af[it] = *(const bf16x8*)(Tm + d * 4608 + (it * 16 + l15) * 72 + ks * 32 + quad * 8);
#pragma unroll
            for (int ct = 0; ct < 4; ++ct)
#pragma unroll
                for (int it = 0; it < 4; ++it) acc[it][ct] = mfma16(bfr[ks][ct], af[it], acc[it][ct]);
        }
#pragma unroll
        for (int it = 0; it < 4; ++it)
#pragma unroll
            for (int ct = 0; ct < 4; ++ct)
                {
                    const int r = it * 16 + l15, i = d ? 63 - r : r, cl = (cq & 1) * 64 + ct * 16 + quad * 4;
                    const f32x4 v = acc[it][ct];
                    u32x2 w;
                    if (cq < 2) { w.x = pk2(v[0], v[1]); w.y = pk2(v[2], v[3]); *(u32x2*)(U0 + i * 128 + cl) = w; }
                    else { w.x = pk2(-v[0], -v[1]); w.y = pk2(-v[2], -v[3]); *(u32x2*)(NW + i * 128 + cl) = w; }
                }
    }
    __syncthreads();
}

__device__ __forceinline__ void token_rows(const Args& a, int l, int m) {
    const int lane = otid() & 63;
    const int b = m / T, t = m - b * T;
    const bf16_t* p = WSP(const bf16_t, WS_P) + (size_t)m * PC;
    unsigned char* mb = a.ws + WS_MLA;
    {
        const unsigned* src = (const unsigned*)(p + OFF_CQ + lane * 6);
        const unsigned w0 = src[0], w1 = src[1], w2 = src[2];
        float v[6] = {bflo(w0), bfhi(w0), bflo(w1), bfhi(w1), bflo(w2), bfhi(w2)};
        float ss = 0.f;
#pragma unroll
        for (int i = 0; i < 6; ++i) ss += v[i] * v[i];
        ss = wave_sum(ss);
        const float r = rsqrtf(ss * (1.0f / 384.0f) + EPS);
        const float* g = a.in[16] + l * 384 + lane * 6;
        unsigned* dst = (unsigned*)((bf16_t*)(mb + A_CQN) + (size_t)m * 384 + lane * 6);
        dst[0] = pk2(v[0] * r * g[0], v[1] * r * g[1]); dst[1] = pk2(v[2] * r * g[2], v[3] * r * g[3]); dst[2] = pk2(v[4] * r * g[4], v[5] * r * g[5]);
    }
    {
        const u32x2 w = *(const u32x2*)(p + OFF_CKV + lane * 4);
        float v[4] = {bflo(w.x), bfhi(w.x), bflo(w.y), bfhi(w.y)};
        float ss = v[0] * v[0] + v[1] * v[1] + v[2] * v[2] + v[3] * v[3];
        ss = wave_sum(ss);
        const float r = rsqrtf(ss * (1.0f / 256.0f) + EPS);
        const float* g = a.in[17] + l * 256 + lane * 4;
        u32x2 o; o.x = pk2(v[0] * r * g[0], v[1] * r * g[1]); o.y = pk2(v[2] * r * g[2], v[3] * r * g[3]);
        *(u32x2*)((bf16_t*)(mb + A_CKVN) + (size_t)m * 256 + lane * 4) = o;
    }
    if (lane < 16) {
        float x1 = bf2f(p[OFF_KR + lane]), x2 = bf2f(p[OFF_KR + 16 + lane]);
        if (t >= CTX) {
            const float* rc = WSP(const float, WS_ROPE); const float* rs = rc + SEQ * 16;
            const int s = t - CTX; const float cs = rc[s * 16 + lane], sn = rs[s * 16 + lane];
            const float o1 = x1 * cs - x2 * sn, o2 = x2 * cs + x1 * sn; x1 = o1; x2 = o2;
        }
        const bf16_t e1 = (bf16_t)f2bf(x1), e2 = (bf16_t)f2bf(x2);
        bf16_t* K = (bf16_t*)(mb + A_K);
#pragma unroll
        for (int hh = 0; hh < 8; ++hh) { bf16_t* kp = K + ((size_t)(b * 8 + hh) * T + t) * 96; kp[64 + lane] = e1; kp[80 + lane] = e2; }
    }
}
__device__ __forceinline__ void phase_m1(const Args& a, int l, unsigned char* lds) {
    for (int item = blockIdx.x; item < NB * 4 * NCH; item += gridDim.x) chunk_item(a, l, item, lds);
    const int wv = otid() >> 6;
    const int nshort = (int)gridDim.x - (NB * 4 * NCH) % (int)gridDim.x, first_short = (int)gridDim.x - nshort;
    if ((int)blockIdx.x >= first_short)
        for (int m = ((int)blockIdx.x - first_short) * 8 + wv; m < M; m += nshort * 8) token_rows(a, l, m);
}

constexpr int SC_NW = 0, SC_Q = SC_NW + 64 * 136 * 2, SC_KT = SC_Q + 64 * 136 * 2, SC_QK = SC_KT + 128 * 72 * 2, SC_U0 = SC_QK + 64 * 72 * 2, SC_GG = SC_U0 + 64 * 32 * 2, SC_IN = SC_GG + 256;
constexpr int SC_ST = 2 * SC_IN, SC_UT = SC_ST + 32 * 136 * 2, SC_UST = SC_UT + 32 * 72 * 2, SC_END = SC_UST + 32 * 72 * 2;
static_assert(SC_END <= LDS_BYTES, "scan LDS map");

struct ScRegs { u32x4 nw0, nw1, q0, q1, k0, k1, qk, u0, g; };
struct ScIdx { int tid, d, b, h, s4; };
__device__ __forceinline__ int sc_chunk(int d, int e) { return (d == 0) ? e : (e < 4 ? 3 - e : 39 - e); }
__device__ __forceinline__ void sc_load(ScRegs& r, const unsigned char* gb, int n, const ScIdx& x) {
    const int tid = x.tid;
    const size_t ci = ((size_t)(x.d * NB + x.b) * 4 + x.h) * NCH + n;
    const u32x4* pNW = (const u32x4*)((const bf16_t*)(gb + G_NW) + ci * 8192); r.nw0 = pNW[tid]; r.nw1 = pNW[tid + 512];
    const u32x4* pQ = (const u32x4*)((const bf16_t*)(gb + G_QN) + ((size_t)(x.b * 4 + x.h) * T + n * 64) * 128); r.q0 = pQ[tid]; r.q1 = pQ[tid + 512];
    const u32x4* pK = (const u32x4*)((const bf16_t*)(gb + G_KT) + ((size_t)(x.b * 4 + x.h) * NCH + n) * 8192); r.k0 = pK[tid]; r.k1 = pK[tid + 512];
    r.qk = ((const u32x4*)((const bf16_t*)(gb + G_QK) + ci * 4096))[tid];
    if (tid < 256) r.u0 = *(const u32x4*)((const bf16_t*)(gb + G_U0) + ci * 8192 + (tid >> 2) * 128 + x.s4 * 32 + (tid & 3) * 8);
    if (tid < 16) r.g = *(const u32x4*)((const float*)(gb + G_GG) + ci * 64 + tid * 4);
}
__device__ __forceinline__ void sc_store(const ScRegs& r, unsigned char* lds, int buf, int tid) {
    unsigned char* ib = lds + buf * SC_IN;
    *(u32x4*)((bf16_t*)(ib + SC_NW) + (tid >> 4) * 136 + (tid & 15) * 8) = r.nw0; *(u32x4*)((bf16_t*)(ib + SC_NW) + ((tid >> 4) + 32) * 136 + (tid & 15) * 8) = r.nw1;
    *(u32x4*)((bf16_t*)(ib + SC_Q) + (tid >> 4) * 136 + (tid & 15) * 8) = r.q0; *(u32x4*)((bf16_t*)(ib + SC_Q) + ((tid >> 4) + 32) * 136 + (tid & 15) * 8) = r.q1;
    *(u32x4*)((bf16_t*)(ib + SC_KT) + (tid >> 3) * 72 + (tid & 7) * 8) = r.k0; *(u32x4*)((bf16_t*)(ib + SC_KT) + ((tid >> 3) + 64) * 72 + (tid & 7) * 8) = r.k1;
    *(u32x4*)((bf16_t*)(ib + SC_QK) + (tid >> 3) * 72 + (tid & 7) * 8) = r.qk;
    if (tid < 256) *(u32x4*)((bf16_t*)(ib + SC_U0) + (tid >> 2) * 32 + (tid & 3) * 8) = r.u0;
    if (tid < 16) *(u32x4*)((float*)(ib + SC_GG) + tid * 4) = r.g;
}
__device__ __forceinline__ void sc_step(unsigned char* lds, int buf, int n, const ScIdx& x, float* Od, f32x4 (&Sacc)[2], const ScRegs& nxt, bool park) {
    const int tid = x.tid, lane = tid & 63, wv = tid >> 6, quad = lane >> 4, l15 = lane & 15, itile = wv >> 1, dvt = wv & 1;
    bf16_t* St = (bf16_t*)(lds + SC_ST); bf16_t* Ut = (bf16_t*)(lds + SC_UT); bf16_t* Ust = (bf16_t*)(lds + SC_UST);
    const unsigned char* ib = lds + buf * SC_IN;
    const bf16_t* NWs = (const bf16_t*)(ib + SC_NW); const bf16_t* Qs = (const bf16_t*)(ib + SC_Q); const bf16_t* KTs = (const bf16_t*)(ib + SC_KT);
    const bf16_t* QKs = (const bf16_t*)(ib + SC_QK); const bf16_t* U0s = (const bf16_t*)(ib + SC_U0); const float* Gs = (const float*)(ib + SC_GG);
    const float Glast = Gs[x.d ? 0 : 63];
    f32x4 U, QS = {0.f, 0.f, 0.f, 0.f};
#pragma unroll
    for (int r = 0; r < 4; ++r) U[r] = bf2f(U0s[(itile * 16 + quad * 4 + r) * 32 + dvt * 16 + l15]);
#pragma unroll
    for (int ks = 0; ks < 4; ++ks) {
        const bf16x8 bfr = *(const bf16x8*)(St + (dvt * 16 + l15) * 136 + ks * 32 + quad * 8);
        const bf16x8 a1 = *(const bf16x8*)(NWs + (itile * 16 + l15) * 136 + ks * 32 + quad * 8);
        const bf16x8 a2 = *(const bf16x8*)(Qs + (itile * 16 + l15) * 136 + ks * 32 + quad * 8);
        U = mfma16(a1, bfr, U); QS = mfma16(a2, bfr, QS);
    }
    {
        float us[4];
#pragma unroll
        for (int r = 0; r < 4; ++r) { const float gi = Gs[itile * 16 + quad * 4 + r]; QS[r] *= __expf(gi); us[r] = U[r] * __expf(Glast - gi); }
        u32x2 w1, w2; w1.x = pk2(U[0], U[1]); w1.y = pk2(U[2], U[3]); w2.x = pk2(us[0], us[1]); w2.y = pk2(us[2], us[3]);
        *(u32x2*)(Ut + (dvt * 16 + l15) * 72 + itile * 16 + quad * 4) = w1;
        *(u32x2*)(Ust + (dvt * 16 + l15) * 72 + itile * 16 + quad * 4) = w2;
    }
    __syncthreads();
#pragma unroll
    for (int ks = 0; ks < 2; ++ks) {
        const bf16x8 a1 = *(const bf16x8*)(QKs + (itile * 16 + l15) * 72 + ks * 32 + quad * 8);
        const bf16x8 b1 = *(const bf16x8*)(Ut + (dvt * 16 + l15) * 72 + ks * 32 + quad * 8);
        QS = mfma16(a1, b1, QS);
    }
#pragma unroll
    for (int r = 0; r < 4; ++r) Od[((size_t)x.b * T + n * 64 + itile * 16 + quad * 4 + r) * 512 + x.h * 128 + x.s4 * 32 + dvt * 16 + l15] = QS[r];
    const float cd = __expf(Glast);
#pragma unroll
    for (int v2 = 0; v2 < 2; ++v2) {
        Sacc[v2] = Sacc[v2] * cd;
#pragma unroll
        for (int ks = 0; ks < 2; ++ks) {
            const bf16x8 a1 = *(const bf16x8*)(KTs + (wv * 16 + l15) * 72 + ks * 32 + quad * 8);
            const bf16x8 b1 = *(const bf16x8*)(Ust + (v2 * 16 + l15) * 72 + ks * 32 + quad * 8);
            Sacc[v2] = mfma16(a1, b1, Sacc[v2]);
        }
        u32x2 w; w.x = pk2(Sacc[v2][0], Sacc[v2][1]); w.y = pk2(Sacc[v2][2], Sacc[v2][3]);
        *(u32x2*)(St + (v2 * 16 + l15) * 136 + wv * 16 + quad * 4) = w;
    }
    if (park) sc_store(nxt, lds, buf ^ 1, tid);
    __syncthreads();
}
__device__ __forceinline__ void phase_scan(const Args& a, unsigned char* lds) {
    const int tid = otid();
    const unsigned char* gb = a.ws + WS_G;
    float* Obase = WSP(float, WS_O);
    for (int item = blockIdx.x; item < 256; item += gridDim.x) {
        const int xc = item & 7, jj = item >> 3, seq = xc * 8 + (jj >> 2);
        ScIdx x; x.tid = tid; x.s4 = jj & 3; x.h = seq & 3; x.b = (seq >> 2) & 7; x.d = seq >> 5;
        float* Od = Obase + (size_t)x.d * M * 512;
        for (int i = tid; i < 32 * 136 / 2; i += 512) ((unsigned*)(lds + SC_ST))[i] = 0u;
        f32x4 Sacc[2]; Sacc[0] = (f32x4){0.f, 0.f, 0.f, 0.f}; Sacc[1] = Sacc[0];
        ScRegs ra, rb; ra.u0 = (u32x4){0u, 0u, 0u, 0u}; ra.g = ra.u0; rb.u0 = ra.u0; rb.g = ra.u0;
        sc_load(ra, gb, sc_chunk(x.d, 0), x); sc_load(rb, gb, sc_chunk(x.d, 1), x);
        sc_store(ra, lds, 0, tid);
        __syncthreads();
#pragma unroll 1
        for (int e = 0; e < NCH; e += 2) {
            if (e + 2 < NCH) sc_load(ra, gb, sc_chunk(x.d, e + 2), x);
            sc_step(lds, 0, sc_chunk(x.d, e), x, Od, Sacc, rb, true);
            if (e + 3 < NCH) sc_load(rb, gb, sc_chunk(x.d, e + 3), x);
            sc_step(lds, 1, sc_chunk(x.d, e + 1), x, Od, Sacc, ra, e + 2 < NCH);
        }
    }
}

constexpr int AT_K = 64 * 104 * 2, AT_V = 64 * 72 * 2, AT_BUF = AT_K + AT_V;
struct AtRegs { u32x4 k0, k1, v; };
struct AtIdx { int tid, kr0, kc0, kr1, kc1; };
__device__ __forceinline__ void at_load(AtRegs& r, const bf16_t* Kg, const bf16_t* Vg, int kt, const AtIdx& x) {
    r.k0 = *(const u32x4*)(Kg + (size_t)(kt * 64 + x.kr0) * 96 + x.kc0 * 8);
    if (x.tid < 256) r.k1 = *(const u32x4*)(Kg + (size_t)(kt * 64 + x.kr1) * 96 + x.kc1 * 8);
    r.v = *(const u32x4*)(Vg + (size_t)(x.tid >> 3) * M + kt * 64 + (x.tid & 7) * 8);
}
__device__ __forceinline__ void at_store(const AtRegs& r, unsigned char* lds, int buf, const AtIdx& x) {
    bf16_t* kb = (bf16_t*)(lds + buf * AT_BUF); bf16_t* vb = (bf16_t*)(lds + buf * AT_BUF + AT_K);
    *(u32x4*)(kb + x.kr0 * 104 + x.kc0 * 8) = r.k0;
    if (x.tid < 256) *(u32x4*)(kb + x.kr1 * 104 + x.kc1 * 8) = r.k1;
    *(u32x4*)(vb + (x.tid >> 3) * 72 + (x.tid & 7) * 8) = r.v;
}
__device__ __forceinline__ void attn_tile(const bf16_t* Kb, const bf16_t* Vb, bool first, const bf16x8 (&qf)[2][3], f32x4 (&o)[2][4], f32x4 (&lacc)[2], float (&mrun)[2], int l15, int quad) {
    const bf16x8 ones = {0x3F80, 0x3F80, 0x3F80, 0x3F80, 0x3F80, 0x3F80, 0x3F80, 0x3F80};
    f32x4 s[2][4];
#pragma unroll
    for (int g = 0; g < 2; ++g)
#pragma unroll
        for (int kk = 0; kk < 4; ++kk) { const float nm = -mrun[g]; s[g][kk] = (f32x4){nm, nm, nm, nm}; }
#pragma unroll
    for (int kk = 0; kk < 4; ++kk)
#pragma unroll
        for (int ks = 0; ks < 3; ++ks) {
            const bf16x8 kf = *(const bf16x8*)(Kb + (kk * 16 + l15) * 104 + ks * 32 + quad * 8);
            s[0][kk] = mfma16(kf, qf[0][ks], s[0][kk]); s[1][kk] = mfma16(kf, qf[1][ks], s[1][kk]);
        }
    bf16x8 pf[2][2];
#pragma unroll
    for (int g = 0; g < 2; ++g) {
        float mx = fmaxf(fmaxf(s[g][0][0], s[g][0][1]), fmaxf(s[g][0][2], s[g][0][3]));
#pragma unroll
        for (int kk = 1; kk < 4; ++kk) mx = fmaxf(fmaxf(mx, fmaxf(s[g][kk][0], s[g][kk][1])), fmaxf(s[g][kk][2], s[g][kk][3]));
        mx = xmax16(mx); mx = xmax32(mx);
        if (first) {
            mrun[g] += mx;
#pragma unroll
            for (int kk = 0; kk < 4; ++kk)
#pragma unroll
                for (int r = 0; r < 4; ++r) s[g][kk][r] = __builtin_amdgcn_exp2f(s[g][kk][r] - mx);
        } else if (__any(mx > 0.f)) {
            const float dl = fmaxf(mx, 0.f), alpha = __builtin_amdgcn_exp2f(-dl);
            mrun[g] += dl;
            lacc[g] = lacc[g] * alpha;
#pragma unroll
            for (int v = 0; v < 4; ++v) o[g][v] = o[g][v] * alpha;
#pragma unroll
            for (int kk = 0; kk < 4; ++kk)
#pragma unroll
                for (int r = 0; r < 4; ++r) s[g][kk][r] = __builtin_amdgcn_exp2f(s[g][kk][r] - dl);
        } else {
#pragma unroll
            for (int kk = 0; kk < 4; ++kk)
#pragma unroll
                for (int r = 0; r < 4; ++r) s[g][kk][r] = __builtin_amdgcn_exp2f(s[g][kk][r]);
        }
#pragma unroll
        for (int k2 = 0; k2 < 2; ++k2) {
            u32x4 w; w.x = pk2(s[g][2 * k2][0], s[g][2 * k2][1]); w.y = pk2(s[g][2 * k2][2], s[g][2 * k2][3]);
            w.z = pk2(s[g][2 * k2 + 1][0], s[g][2 * k2 + 1][1]); w.w = pk2(s[g][2 * k2 + 1][2], s[g][2 * k2 + 1][3]);
            pf[g][k2] = __builtin_bit_cast(bf16x8, w);
            lacc[g] = mfma16(ones, pf[g][k2], lacc[g]);
        }
    }
#pragma unroll
    for (int k2 = 0; k2 < 2; ++k2)
#pragma unroll
        for (int v = 0; v < 4; ++v) {
            const u32x2 lo = *(const u32x2*)(Vb + (v * 16 + l15) * 72 + k2 * 32 + quad * 4), hi = *(const u32x2*)(Vb + (v * 16 + l15) * 72 + k2 * 32 + 16 + quad * 4);
            u32x4 w; w.x = lo.x; w.y = lo.y; w.z = hi.x; w.w = hi.y;
            const bf16x8 vf = __builtin_bit_cast(bf16x8, w);
            o[0][v] = mfma16(vf, pf[0][k2], o[0][v]); o[1][v] = mfma16(vf, pf[1][k2], o[1][v]);
        }
}
__device__ __forceinline__ void attn_item(const Args& a, int item, unsigned char* lds) {
    const int tid = otid(), lane = tid & 63, wv = tid >> 6, quad = lane >> 4, l15 = lane & 15;
    int b, h, qb;
    if (item < 512) {
        const int r = item >> 8, c = item & 255, x = c & 7, j = c >> 3, bh = r * 32 + x * 4 + (j >> 3);
        qb = 1 + (j & 7); h = bh & 7; b = bh >> 3;
    } else { const int i2 = item - 512; qb = 0; h = i2 & 7; b = i2 >> 3; }
    const int nkt = qb == 0 ? 4 : NCH;
    unsigned char* mb = a.ws + WS_MLA;
    const bf16_t* Qg = (const bf16_t*)(mb + A_Q) + (size_t)(b * 8 + h) * T * 96;
    const bf16_t* Kg = (const bf16_t*)(mb + A_K) + (size_t)(b * 8 + h) * T * 96;
    const bf16_t* Vg = (const bf16_t*)(mb + A_VT) + (size_t)(h * 64) * M + (size_t)b * T;
    AtIdx x; x.tid = tid; x.kr0 = tid / 12; x.kc0 = tid - x.kr0 * 12; x.kr1 = (tid + 512) / 12; x.kc1 = (tid + 512) - x.kr1 * 12;
    AtRegs ra, rb; ra.k1 = (u32x4){0u, 0u, 0u, 0u}; rb.k1 = ra.k1;
    at_load(ra, Kg, Vg, 0, x); at_load(rb, Kg, Vg, 1, x);
    bf16x8 qf[2][3];
#pragma unroll
    for (int g = 0; g < 2; ++g)
#pragma unroll
        for (int ks = 0; ks < 3; ++ks) qf[g][ks] = *(const bf16x8*)(Qg + (size_t)(qb * 256 + wv * 32 + g * 16 + l15) * 96 + ks * 32 + quad * 8);
    f32x4 o[2][4], lacc[2]; float mrun[2];
#pragma unroll
    for (int g = 0; g < 2; ++g) { mrun[g] = 0.f; lacc[g] = (f32x4){0.f, 0.f, 0.f, 0.f};
#pragma unroll
        for (int v = 0; v < 4; ++v) o[g][v] = (f32x4){0.f, 0.f, 0.f, 0.f}; }
    AtRegs rc; rc.k1 = ra.k1;
    at_load(rc, Kg, Vg, 2, x);
    at_store(ra, lds, 0, x); at_store(rb, lds, 1, x); at_store(rc, lds, 2, x);
    at_load(ra, Kg, Vg, 3, x); if (4 < nkt) at_load(rb, Kg, Vg, 4, x); if (5 < nkt) at_load(rc, Kg, Vg, 5, x);
    __syncthreads();
#pragma unroll 1
    for (int kt = 0; kt < nkt; kt += 3) {
        { const int b0 = kt % 6; attn_tile((const bf16_t*)(lds + b0 * AT_BUF), (const bf16_t*)(lds + b0 * AT_BUF + AT_K), kt == 0, qf, o, lacc, mrun, l15, quad); }
        if (kt + 1 < nkt) { const int b1 = (kt + 1) % 6; attn_tile((const bf16_t*)(lds + b1 * AT_BUF), (const bf16_t*)(lds + b1 * AT_BUF + AT_K), false, qf, o, lacc, mrun, l15, quad); }
        if (kt + 2 < nkt) { const int b2 = (kt + 2) % 6; attn_tile((const bf16_t*)(lds + b2 * AT_BUF), (const bf16_t*)(lds + b2 * AT_BUF + AT_K), false, qf, o, lacc, mrun, l15, quad); }
        if (kt + 3 < nkt) at_store(ra, lds, (kt + 3) % 6, x);
        if (kt + 4 < nkt) at_store(rb, lds, (kt + 4) % 6, x);
        if (kt + 5 < nkt) at_store(rc, lds, (kt + 5) % 6, x);
        if (kt + 6 < nkt) at_load(ra, Kg, Vg, kt + 6, x);
        if (kt + 7 < nkt) at_load(rb, Kg, Vg, kt + 7, x);
        if (kt + 8 < nkt) at_load(rc, Kg, Vg, kt + 8, x);
        __syncthreads();
    }
    bf16_t* mix = WSP(bf16_t, WS_H);
#pragma unroll
    for (int g = 0; g < 2; ++g) {
        const float inv = 1.0f / lacc[g][0];
        const int t = qb * 256 + wv * 32 + g * 16 + l15;
        bf16_t* dst = mix + ((size_t)b * T + t) * 1024 + 512 + h * 64 + quad * 4;
#pragma unroll
        for (int v = 0; v < 4; ++v) { u32x2 w; w.x = pk2(o[g][v][0] * inv, o[g][v][1] * inv); w.y = pk2(o[g][v][2] * inv, o[g][v][3] * inv); *(u32x2*)(dst + v * 16) = w; }
    }
}
__device__ __forceinline__ void combine_row(const Args& a, int l, int m) {
    const int lane = otid() & 63, hh = lane >> 4, c0 = (lane & 15) * 8;
    const float* Of = WSP(const float, WS_O) + (size_t)m * 512 + hh * 128 + c0; const float* Ob = Of + (size_t)M * 512;
    const f32x4 a0 = *(const f32x4*)Of + *(const f32x4*)Ob, a1 = *(const f32x4*)(Of + 4) + *(const f32x4*)(Ob + 4);
    float ss = a0[0] * a0[0] + a0[1] * a0[1] + a0[2] * a0[2] + a0[3] * a0[3] + a1[0] * a1[0] + a1[1] * a1[1] + a1[2] * a1[2] + a1[3] * a1[3];
#pragma unroll
    for (int o = 8; o >= 1; o >>= 1) ss += __shfl_xor(ss, o);
    const float r = rsqrtf(ss * (1.0f / 128.0f) + EPS);
    const float* gn = a.in[15] + l * 128 + c0;
    const u32x4 zw = *(const u32x4*)(WSP(const bf16_t, WS_P) + (size_t)m * PC + OFF_Z + hh * 128 + c0);
    const float z[8] = {bflo(zw.x), bfhi(zw.x), bflo(zw.y), bfhi(zw.y), bflo(zw.z), bfhi(zw.z), bflo(zw.w), bfhi(zw.w)};
    float v[8];
#pragma unroll
    for (int i = 0; i < 4; ++i) { v[i] = a0[i] * r * gn[i] * silu_f(z[i]); v[4 + i] = a1[i] * r * gn[4 + i] * silu_f(z[4 + i]); }
    u32x4 w; w.x = pk2(v[0], v[1]); w.y = pk2(v[2], v[3]); w.z = pk2(v[4], v[5]); w.w = pk2(v[6], v[7]);
    *(u32x4*)(WSP(bf16_t, WS_H) + (size_t)m * 1024 + hh * 128 + c0) = w;
}

struct RemapOrder {
    pg8::StaticOrder S; int remap;
    __device__ __forceinline__ bool next(int i, pg8::Unit& u) const { const bool r = S.next(i, u); if (r && remap) u.pm = (u.pm >> 3) * 9 + 1 + (u.pm & 7); return r; }
    __device__ __forceinline__ void a_ready(const pg8::Unit&) const {}
    __device__ __forceinline__ void done(const pg8::Unit&) const {}
};
template <class Epi> __device__ __forceinline__ void run_gemm(unsigned char* lds, const bf16_t* A, const bf16_t* Bt, int Mr, int N, int K, int rot, const Epi& E, int latent_only = 0) {
    pg8::Gemm g{A, Bt, Mr, N, K}; RemapOrder S; S.S.init(latent_only ? 64 * 256 : Mr, N, (int)gridDim.x, (int)((blockIdx.x + rot) % gridDim.x)); S.remap = latent_only;
    pg8::gemm_phase<Epi, RemapOrder, true, true>((PG8_LAS unsigned char*)lds, g, S, E);
}
__device__ __forceinline__ void run_gemm_fused(unsigned char* lds, const bf16_t* A, const bf16_t* Bt, int K, const EpiResNorm& E, int latent_only) {
    pg8::Gemm g{A, Bt, M, D, K}; PanelOrder S; S.c = (int)blockIdx.x; S.latent_only = latent_only;
    pg8::gemm_phase<EpiResNorm, PanelOrder, true, true>((PG8_LAS unsigned char*)lds, g, S, E);
}

__global__ void __launch_bounds__(512, 2) mega_fwd(Args a) {
    extern __shared__ __attribute__((aligned(16))) unsigned char lds[];
    cg::grid_group grid = cg::this_grid();
    volatile LAS unsigned* bst = (volatile LAS unsigned*)((LAS unsigned char*)lds + LDS_BYTES - 16);
    if (threadIdx.x < 4) bst[threadIdx.x] = 0u;
    __syncthreads();
    XcdBarrier xbar; xbar.bar = (unsigned*)(a.ws + WS_BAR); xbar.x = 0; xbar.st = nullptr;
    if (a.coop == 1 && blockIdx.x == 0) for (int i = threadIdx.x; i < 5120; i += 512) ((unsigned*)(a.ws + WS_BAR))[i] = 0u;
    unsigned char* wt = a.ws + WS_WT;
    unsigned char* mb = a.ws + WS_MLA;
    const float* mod = WSP(const float, WS_MOD);
    constexpr int LAST_PH = 12 * DEPTH;
#pragma unroll 1
    for (int ph = a.ph_lo; ph < a.ph_hi; ++ph) {
        const int l = (ph - 1) / 12, k = (ph - 1) % 12;
        if (ph > LAST_PH) continue;
        if (ph > 0 && ((k == 0 && l > 0) || k == 3 || k == 9)) continue;
        if (ph == 0) {
            phase_mod(a, lds);
            __syncthreads();
            phase_transpose(a, 0, lds, 0, 296, 0);
        } else if (k == 0) {
            RowCfg c{1, 0, 0, 0, 1, 0, 0, 0, 0.5f};
            phase_rowpass(a, c);
        } else if (k == 1 || k == 10) {
            EpiGU E{WSP(bf16_t, WS_ACT), DFF};
            run_gemm(lds, WSP(const bf16_t, WS_H), (const bf16_t*)(wt + (k == 1 ? WT_GU0 : WT_GU1)), M, 2 * DFF, D, 0, E, (k == 10 && l == DEPTH - 1) ? 1 : 0);
        } else if (k == 2 || k == 8 || k == 11) {
            const int slot = (k == 2) ? 0 : (k == 8 ? 1 : 2);
            const bool fin = (k == 11 && l == DEPTH - 1);
            const int pl = (k == 11) ? l + 1 : l, ps = (k == 11) ? 0 : slot + 1;
            EpiResNorm E;
            E.X = WSP(float, WS_X); E.H = WSP(bf16_t, WS_H); E.out = fin ? a.out : nullptr;
            E.gate_base = mod + (size_t)l * 9 * 9216 + (3 * slot + 2) * 1024; E.gpost = a.in[7] + (size_t)(l * 3 + slot) * D; E.post_w = (k == 8) ? 1.0f : 0.5f;
            E.shift_base = mod + (size_t)(fin ? l : pl) * 9 * 9216 + (3 * ps) * 1024; E.gpre = a.in[6] + (size_t)((fin ? l : pl) * 3 + ps) * D;
            E.slots = WSP(float, WS_XCH); E.cnt = WSP(unsigned, WS_CNT) + (l * 3 + slot) * 72; E.lds = lds;
            const int lat = (l == DEPTH - 1 && k != 2) ? 1 : 0;
            if (k == 8) run_gemm_fused(lds, WSP(const bf16_t, WS_H), (const bf16_t*)(wt + WT_WOUT), D, E, lat);
            else run_gemm_fused(lds, WSP(const bf16_t, WS_ACT), (const bf16_t*)(wt + (k == 2 ? WT_DN0 : WT_DN1)), DFF, E, lat);
            if (k == 2) {
                __syncthreads();
                if (l > 0) phase_transpose(a, l, lds, 192, 208, 32);
                if (l + 1 < DEPTH) phase_transpose(a, l + 1, lds, 0, 88, 32);
            } else if (k == 11 && l + 1 < DEPTH) {
                __syncthreads();
                phase_transpose(a, l + 1, lds, 88, 192, 32);
                phase_transpose(a, l + 1, lds, 208, 296, 32);
            }
        } else if (k == 4) {
            EpiBf16 E{WSP(bf16_t, WS_P), PC};
            run_gemm(lds, WSP(const bf16_t, WS_H), (const bf16_t*)(wt + WT_WIN), M, PC, D, 0, E);
        } else if (k == 5) {
            phase_m1(a, l, lds);
        } else if (k == 6) {
            phase_scan(a, lds);
            __syncthreads();
            { EpiQ E{(bf16_t*)(mb + A_Q), WSP(const float, WS_ROPE), WSP(const float, WS_ROPE) + SEQ * 16};
              run_gemm(lds, (const bf16_t*)(mb + A_CQN), (const bf16_t*)(wt + WT_WUQ), M, 768, 384, 0, E); }
            { EpiK E{(bf16_t*)(mb + A_K)};
              run_gemm(lds, (const bf16_t*)(mb + A_CKVN), (const bf16_t*)(wt + WT_WK), M, 512, 256, 40, E); }
            { EpiBf16 E{(bf16_t*)(mb + A_VT), M};
              run_gemm(lds, (const bf16_t*)(wt + WT_WV), (const bf16_t*)(mb + A_CKVN), 512, M, 256, 152, E); }
        } else if (k == 7) {
            const bool lastl = (l == DEPTH - 1);
            for (int item = blockIdx.x; item < (lastl ? 512 : 576); item += gridDim.x) attn_item(a, item, lds);
            const int wv = otid() >> 6;
            for (int m = blockIdx.x * 8 + wv; m < M; m += gridDim.x * 8) { if (lastl && (m % T) < CTX) continue; combine_row(a, l, m); }
        }
        if (ph + 1 < a.ph_hi && ph < LAST_PH) {
            if (a.coop == 1) {
                if (ph == a.ph_lo) { grid.sync(); xbar = xcd_barrier_post((unsigned*)(a.ws + WS_BAR), bst); }
                else xcd_barrier(xbar);
            }
            else if (a.coop == 2) grid.sync();
        }
    }
}

#ifndef MK_MULTI
#define MK_MULTI 0
#endif
extern "C" void kernel_launch(void* const* d_in, const int* in_sizes, int n_in, void* d_out, int out_size, void* d_ws, size_t ws_size, hipStream_t stream) {
    static int grid = 0;
    if (grid == 0) {
        int dev = 0, cus = 0, per_cu = 0;
        hipGetDevice(&dev);
        hipDeviceGetAttribute(&cus, hipDeviceAttributeMultiprocessorCount, dev);
        hipFuncSetAttribute((const void*)mega_fwd, hipFuncAttributeMaxDynamicSharedMemorySize, LDS_BYTES);
        hipOccupancyMaxActiveBlocksPerMultiprocessor(&per_cu, (const void*)mega_fwd, 512, LDS_BYTES);
        if (per_cu < 1) per_cu = 1;
        if (cus < 1) cus = 256;
        grid = cus * per_cu;
        if (grid > 256) grid = 256;
        (void)hipGetLastError();
        if (ws_size < WS_END) fprintf(stderr, "kernel_launch: workspace too small: %zu < %zu\n", ws_size, (size_t)WS_END);
    }
    Args a{};
    for (int i = 0; i < 21; ++i) a.in[i] = (const float*)d_in[i];
    a.out = (float*)d_out; a.ws = (unsigned char*)d_ws;
#if MK_MULTI
    for (int ph = 0; ph < NPHASE; ++ph) {
        a.ph_lo = ph; a.ph_hi = ph + 1; a.coop = 0;
        hipLaunchKernelGGL(mega_fwd, dim3(grid), dim3(512), LDS_BYTES, stream, a);
    }
#else
    a.ph_lo = 0; a.ph_hi = NPHASE; a.coop = 1;
    void* args[] = {&a};
    hipError_t e = hipLaunchCooperativeKernel((const void*)mega_fwd, dim3(grid), dim3(512), args, LDS_BYTES, stream);
    if (e != hipSuccess) fprintf(stderr, "cooperative launch failed: %s (grid %d)\n", hipGetErrorString(e), grid);
#endif
}
```

```cpp
#include <hip/hip_runtime.h>
#include <hip/hip_cooperative_groups.h>
#include <cstdio>
#include <cstdint>
namespace cg = cooperative_groups;
#ifndef PROBE_MASK
#define PROBE_MASK 0
#endif
namespace pg8 {
#define PG8_LAS __attribute__((address_space(3)))
typedef unsigned short bf16_t;
typedef short bf16x8 __attribute__((ext_vector_type(8)));
typedef float f32x4 __attribute__((ext_vector_type(4)));
typedef unsigned u32x4 __attribute__((ext_vector_type(4)));
constexpr int BM = 256, BK = 64, HALF = 128, HTB = HALF * BK * 2  , STAGE_BYTES = 8 * HTB, NXCD = 8, WGM = 8;

__host__ __device__ __forceinline__ int lds_byte(int r, int c) { const int st = (r >> 4) * 2 + (c >> 5), rr = r & 15, cc = c & 31, ob = rr * 64 + cc * 2; return st * 1024 + (ob ^ (((ob >> 9) & 1) << 5)); }
__host__ __device__ __forceinline__ void stage_rc(int b, int& R, int& C) { const int st = b / 1024, sb = b % 1024, swz = sb ^ (((sb >> 9) & 1) << 5); R = (st >> 1) * 16 + swz / 64; C = (st & 1) * 32 + (swz % 64) / 2; }
__host__ __device__ __forceinline__ int perm32(int rho) { const int n = rho >> 4, i = rho & 15; return 8 * (i >> 2) + 4 * n + (i & 3); }

struct Unit { int pm, pn; };
struct Gemm { const bf16_t* A; const bf16_t* Bt; int M, N, K; };

struct StaticOrder {
    int nM, nN, nwg, G, c;
    __host__ __device__ void init(int M, int N, int G_, int c_) { nM = M / BM; nN = N / BM; nwg = nM * nN; G = G_; c = c_; }
    __host__ __device__ bool next(int i, Unit& u) const {
        const long L = (long)i * G + c; if (L >= nwg) return false;
        int wgid = (int)L; { const int q = nwg / NXCD, r = nwg % NXCD, xcd = wgid % NXCD, off = wgid / NXCD; wgid = (xcd < r ? xcd * (q + 1) : r * (q + 1) + (xcd - r) * q) + off; }
        const int nig = WGM * nN, gid = wgid / nig, fm = gid * WGM, gsz = (nM - fm) < WGM ? (nM - fm) : WGM;
        u.pm = fm + ((wgid % nig) % gsz); u.pn = (wgid % nig) / gsz; return true;
    }
    __device__ __forceinline__ void a_ready(const Unit&) const {}
    __device__ __forceinline__ void done(const Unit&) const {}
};
template <class Epi, class Sched, bool ALIGN_EPI = false, bool SP2 = false>
__device__ __forceinline__ void gemm_phase(PG8_LAS unsigned char* lds, const Gemm g, const Sched& S, const Epi& E) {
    int tid_l = threadIdx.x; asm volatile("" : "+v"(tid_l));
    const int tid = tid_l, wid = __builtin_amdgcn_readfirstlane(tid >> 6), lane = tid & 63, wr = wid >> 2, wc = wid & 3, fr = lane & 15, fq = lane >> 4;
    const int K = g.K, nt = K / BK;
    unsigned voffA[2], voffB[2];
#pragma unroll
    for (int i = 0; i < 2; ++i) { int R, C; stage_rc(tid * 16 + i * 8192, R, C); const int Rb = Epi::PERM ? ((R & ~31) + perm32(R & 31)) : R;
        voffA[i] = (unsigned)(R * K + C) * 2u; voffB[i] = (unsigned)(Rb * K + C) * 2u; }
    const size_t kstep = (size_t)(BK * 2);
    const size_t hstep = (size_t)HALF * K * 2;
    const size_t tstep = 2 * hstep;
    const unsigned ldsw = (unsigned)wid * 1024u;
    const int aoff = lds_byte(wr * 64 + fr, fq * 8), boff = lds_byte(wc * 32 + fr, fq * 8);
#define PG8_SA(b, h) (((b) * 2 + (h)) * HTB)
#define PG8_SB(b, h) ((4 + (b) * 2 + (h)) * HTB)
#define PG8_STAGE(bufoff, gbase, voff) do { _Pragma("unroll") for (int _i = 0; _i < 2; ++_i) \
        __builtin_amdgcn_global_load_lds((const unsigned*)((const char*)(gbase) + (voff)[_i]), (PG8_LAS unsigned*)(lds + (bufoff) + ldsw + _i * 8192), 16, 0, 0); } while (0)
#define PG8_LDA(dst, b, h) do { _Pragma("unroll") for (int m = 0; m < 4; ++m) _Pragma("unroll") for (int k = 0; k < 2; ++k) dst[m][k] = *(const PG8_LAS bf16x8*)(lds + PG8_SA(b, h) + aoff + m * 2048 + k * 1024); } while (0)
#define PG8_LDB(dst, b, h) do { _Pragma("unroll") for (int n = 0; n < 2; ++n) _Pragma("unroll") for (int k = 0; k < 2; ++k) dst[n][k] = *(const PG8_LAS bf16x8*)(lds + PG8_SB(b, h) + boff + n * 2048 + k * 1024); } while (0)
#define PG8_MMA(ai, bj, At, Bt) do { __builtin_amdgcn_s_setprio(1); _Pragma("unroll") for (int m = 0; m < 4; ++m) _Pragma("unroll") for (int n = 0; n < 2; ++n) _Pragma("unroll") for (int k = 0; k < 2; ++k) \
        acc[ai][bj][m][n] = __builtin_amdgcn_mfma_f32_16x16x32_bf16(Bt[n][k], At[m][k], acc[ai][bj][m][n], 0, 0, 0); __builtin_amdgcn_s_setprio(0); } while (0)
#define PG8_WAIT_V(n) asm volatile("s_waitcnt vmcnt(" #n ")" ::: "memory")
#define PG8_WAIT_L(n) asm volatile("s_waitcnt lgkmcnt(" #n ")" ::: "memory")
#define PG8_BAR __builtin_amdgcn_s_barrier()
#define PG8_SCHED __builtin_amdgcn_sched_barrier(0)
    Unit cur, nxt; int ui = 0;
    if (!S.next(0, cur)) return;
    f32x4 acc[2][2][4][2];
#pragma unroll
    for (int a = 0; a < 2; ++a)
#pragma unroll
        for (int b = 0; b < 2; ++b)
#pragma unroll
            for (int m = 0; m < 4; ++m)
#pragma unroll
                for (int n = 0; n < 2; ++n) acc[a][b][m][n] = (f32x4){0.f, 0.f, 0.f, 0.f};
    bf16x8 At[4][2], B0[2][2], B1[2][2];
    const char* cA = (const char*)g.A + (size_t)cur.pm * tstep; const char* cB = (const char*)g.Bt + (size_t)cur.pn * tstep;
    S.a_ready(cur);
    if constexpr (SP2) {
        PG8_STAGE(PG8_SB(0, 0), cB, voffB); PG8_STAGE(PG8_SB(0, 1), cB + hstep, voffB); PG8_STAGE(PG8_SA(0, 0), cA, voffA); PG8_STAGE(PG8_SA(0, 1), cA + hstep, voffA);
        if (wr == 1) PG8_BAR;
        PG8_WAIT_V(2); PG8_BAR;
        PG8_STAGE(PG8_SB(1, 0), cB + kstep, voffB); PG8_STAGE(PG8_SA(1, 0), cA + kstep, voffA); PG8_STAGE(PG8_SB(1, 1), cB + hstep + kstep, voffB);
        PG8_WAIT_V(6); PG8_BAR;
    } else {
        PG8_STAGE(PG8_SB(0, 0), cB, voffB); PG8_STAGE(PG8_SA(0, 0), cA, voffA); PG8_STAGE(PG8_SB(0, 1), cB + hstep, voffB); PG8_STAGE(PG8_SA(0, 1), cA + hstep, voffA);
        if (wr == 1) PG8_BAR;
        PG8_WAIT_V(4); PG8_BAR;
        PG8_STAGE(PG8_SB(1, 0), cB + kstep, voffB); PG8_STAGE(PG8_SA(1, 0), cA + kstep, voffA); PG8_STAGE(PG8_SB(1, 1), cB + hstep + kstep, voffB);
        PG8_WAIT_V(6); PG8_BAR;
    }
    for (;;) {
        const bool has_next = S.next(ui + 1, nxt);
        const char* nA = has_next ? (const char*)g.A + (size_t)nxt.pm * tstep : cA; const char* nB = has_next ? (const char*)g.Bt + (size_t)nxt.pn * tstep : cB;
_Pragma("unroll 1")
        for (int t = 0; t < nt; t += 2) {
            const bool last = (t == nt - 2);
            const char* a1 = cA + (size_t)(t + 1) * kstep;
            const char* a2 = last ? nA : cA + (size_t)(t + 2) * kstep; const char* b2 = last ? nB : cB + (size_t)(t + 2) * kstep;
            const char* a3 = a2 + kstep; const char* b3 = b2 + kstep;
            if (last && has_next) S.a_ready(nxt);
            if constexpr (SP2) {
            PG8_LDB(B0, 0, 0); PG8_LDB(B1, 0, 1); PG8_SCHED; PG8_LDA(At, 0, 0); PG8_STAGE(PG8_SA(1, 1), a1 + hstep, voffA);
            PG8_WAIT_V(8); PG8_WAIT_L(0); PG8_BAR; PG8_MMA(0, 0, At, B0); PG8_MMA(0, 1, At, B1); PG8_BAR; PG8_SCHED;
            PG8_LDA(At, 0, 1); PG8_STAGE(PG8_SB(0, 0), b2, voffB); PG8_STAGE(PG8_SB(0, 1), b2 + hstep, voffB); PG8_STAGE(PG8_SA(0, 0), a2, voffA);
            PG8_WAIT_V(8); PG8_WAIT_L(0); PG8_BAR; PG8_MMA(1, 0, At, B0); PG8_MMA(1, 1, At, B1); PG8_BAR; PG8_SCHED;
            PG8_LDB(B0, 1, 0); PG8_LDB(B1, 1, 1); PG8_SCHED; PG8_LDA(At, 1, 0); PG8_STAGE(PG8_SA(0, 1), a2 + hstep, voffA);
            PG8_WAIT_V(8); PG8_WAIT_L(0); PG8_BAR; PG8_MMA(0, 0, At, B0); PG8_MMA(0, 1, At, B1); PG8_BAR; PG8_SCHED;
            PG8_LDA(At, 1, 1); PG8_STAGE(PG8_SB(1, 0), b3, voffB); PG8_STAGE(PG8_SB(1, 1), b3 + hstep, voffB); PG8_STAGE(PG8_SA(1, 0), a3, voffA);
            PG8_WAIT_V(8); PG8_WAIT_L(0); PG8_BAR; PG8_MMA(1, 0, At, B0); PG8_MMA(1, 1, At, B1); PG8_BAR; PG8_SCHED;
            } else {
            PG8_LDB(B0, 0, 0); PG8_SCHED; PG8_LDA(At, 0, 0); PG8_STAGE(PG8_SA(1, 1), a1 + hstep, voffA);
            PG8_WAIT_L(8); PG8_BAR; PG8_WAIT_L(0); PG8_MMA(0, 0, At, B0); PG8_BAR; PG8_SCHED;
            PG8_LDB(B1, 0, 1); PG8_STAGE(PG8_SB(0, 0), b2, voffB);
            PG8_BAR; PG8_WAIT_L(0); PG8_MMA(0, 1, At, B1); PG8_BAR;
            PG8_LDA(At, 0, 1); PG8_STAGE(PG8_SA(0, 0), a2, voffA);
            PG8_BAR; PG8_WAIT_L(0); PG8_MMA(1, 0, At, B0); PG8_BAR; PG8_SCHED;
            PG8_STAGE(PG8_SB(0, 1), b2 + hstep, voffB);
            PG8_WAIT_V(6); PG8_BAR; PG8_MMA(1, 1, At, B1); PG8_BAR;
            PG8_LDB(B0, 1, 0); PG8_SCHED; PG8_LDA(At, 1, 0); PG8_STAGE(PG8_SA(0, 1), a2 + hstep, voffA);
            PG8_WAIT_L(8); PG8_BAR; PG8_WAIT_L(0); PG8_MMA(0, 0, At, B0); PG8_BAR; PG8_SCHED;
            PG8_LDB(B1, 1, 1); PG8_STAGE(PG8_SB(1, 0), b3, voffB);
            PG8_BAR; PG8_WAIT_L(0); PG8_MMA(0, 1, At, B1); PG8_BAR;
            PG8_LDA(At, 1, 1); PG8_STAGE(PG8_SA(1, 0), a3, voffA);
            PG8_BAR; PG8_WAIT_L(0); PG8_MMA(1, 0, At, B0); PG8_BAR; PG8_SCHED;
            PG8_STAGE(PG8_SB(1, 1), b3 + hstep, voffB);
            PG8_WAIT_V(6); PG8_BAR; PG8_MMA(1, 1, At, B1); PG8_BAR;
            }
        }
        if constexpr (ALIGN_EPI) { if (wr == 0) PG8_BAR; }
        if constexpr (!Epi::AFTER_DRAIN) { E(acc, cur, wr, wc, fr, fq); S.done(cur); }
        if (!has_next) break;
#pragma unroll
        for (int a = 0; a < 2; ++a)
#pragma unroll
            for (int b = 0; b < 2; ++b)
#pragma unroll
                for (int m = 0; m < 4; ++m)
#pragma unroll
                    for (int n = 0; n < 2; ++n) acc[a][b][m][n] = (f32x4){0.f, 0.f, 0.f, 0.f};
        cur = nxt; cA = nA; cB = nB; ++ui;
        if constexpr (ALIGN_EPI) { if (wr == 1) PG8_BAR; }
    }
    PG8_WAIT_V(0);
    if constexpr (!ALIGN_EPI) { if (wr == 0) PG8_BAR; }
    PG8_BAR;
    if constexpr (Epi::AFTER_DRAIN) { E.fused(acc, cur, wr, wc, fr, fq, lds, wid, lane); S.done(cur); }
#undef PG8_SA
#undef PG8_SB
#undef PG8_STAGE
#undef PG8_LDA
#undef PG8_LDB
#undef PG8_MMA
#undef PG8_WAIT_V
#undef PG8_WAIT_L
#undef PG8_BAR
#undef PG8_SCHED
}
}

using pg8::bf16_t; using pg8::bf16x8; using pg8::f32x4;
typedef unsigned u32x4 __attribute__((ext_vector_type(4)));
typedef unsigned u32x2 __attribute__((ext_vector_type(2)));
typedef short s16x4 __attribute__((ext_vector_type(4)));

constexpr int NB = 8, SEQ = 2048, CTX = 256, T = CTX + SEQ, D = 1024, M = NB * T, DEPTH = 4, DFF = 2816, PC = 2816;
constexpr int NCH = T / 64;
constexpr float EPS = 1e-6f;
constexpr int OFF_Z = 1536, OFF_A = 2048, OFF_B = 2056, OFF_CQ = 2064, OFF_CKV = 2448, OFF_KR = 2704, IN_COLS = 2736;
constexpr float QSCALE = 0.10206207261596575f * 1.4426950408889634f;
constexpr int NPHASE = 2 + 12 * DEPTH;
constexpr int LDS_BYTES = 155648;

constexpr size_t al256(size_t x) { return (x + 255) & ~(size_t)255; }
constexpr size_t WS_MOD = 0;
constexpr size_t WS_ROPE = al256(WS_MOD + (size_t)DEPTH * 9 * 9216 * 4);
constexpr size_t WS_X = al256(WS_ROPE + (size_t)2 * SEQ * 16 * 4);
constexpr size_t WS_H = al256(WS_X + (size_t)M * D * 4);
constexpr size_t WS_WT = al256(WS_H + (size_t)M * D * 2);
constexpr size_t WT_GU0 = 0, WT_GU1 = WT_GU0 + (size_t)2 * DFF * D * 2, WT_DN0 = WT_GU1 + (size_t)2 * DFF * D * 2, WT_DN1 = WT_DN0 + (size_t)D * DFF * 2,
                 WT_WIN = WT_DN1 + (size_t)D * DFF * 2, WT_WUQ = WT_WIN + (size_t)PC * D * 2, WT_WK = WT_WUQ + (size_t)768 * 384 * 2, WT_WV = WT_WK + (size_t)512 * 256 * 2,
                 WT_WOUT = WT_WV + (size_t)512 * 256 * 2, WT_END = WT_WOUT + (size_t)D * D * 2;
constexpr size_t WS_P = al256(WS_WT + WT_END);
constexpr size_t WS_Y = WS_P;
constexpr size_t WS_G = al256(WS_P + (size_t)M * PC * 2);
constexpr size_t NCI = (size_t)2 * NB * 4 * NCH;
constexpr size_t G_NW = 0, G_U0 = G_NW + NCI * 8192 * 2, G_QK = G_U0 + NCI * 8192 * 2, G_GG = G_QK + NCI * 4096 * 2, G_QN = G_GG + NCI * 64 * 4,
                 G_KT = G_QN + (size_t)NB * 4 * T * 128 * 2, G_END = G_KT + (size_t)NB * 4 * T * 128 * 2;
constexpr size_t WS_ACT = WS_G;
static_assert(G_END >= (size_t)M * PC * 2, "ACT fits in the GDN region");
constexpr size_t WS_O = al256(WS_G + G_END);
constexpr size_t WS_MLA = al256(WS_O + (size_t)2 * M * 512 * 4);
constexpr size_t A_CQN = 0, A_CKVN = A_CQN + (size_t)M * 384 * 2, A_Q = A_CKVN + (size_t)M * 256 * 2, A_K = A_Q + (size_t)M * 768 * 2, A_VT = A_K + (size_t)M * 768 * 2,
                 A_END = A_VT + (size_t)512 * M * 2;
constexpr size_t WS_BAR = al256(WS_MLA + A_END);
constexpr size_t WS_CNT = WS_BAR + 16384;
constexpr size_t WS_XCH = WS_CNT + 4096;
constexpr size_t WS_END = WS_XCH + (size_t)72 * 4 * 256 * 16;
static_assert(WS_END <= (size_t)603979776, "workspace map must fit 4x the largest input");

struct Args { const float* in[21]; float* out; unsigned char* ws; int ph_lo, ph_hi, coop, pad; };

__device__ __forceinline__ int otid() { int t = threadIdx.x; asm volatile("" : "+v"(t)); return t; }
__device__ __forceinline__ unsigned f2bf(float f) { unsigned u = __float_as_uint(f); return (u + 0x7fffu + ((u >> 16) & 1u)) >> 16; }
typedef float f32x2_t __attribute__((ext_vector_type(2))); typedef __bf16 bf16x2_t __attribute__((ext_vector_type(2)));
__device__ __forceinline__ unsigned pk2(float lo, float hi) { f32x2_t v = {lo, hi}; bf16x2_t b = __builtin_convertvector(v, bf16x2_t); return __builtin_bit_cast(unsigned, b); }
__device__ __forceinline__ float bf2f(unsigned short v) { return __uint_as_float((unsigned)v << 16); }
__device__ __forceinline__ float bflo(unsigned w) { return __uint_as_float(w << 16); }
__device__ __forceinline__ float bfhi(unsigned w) { return __uint_as_float(w & 0xffff0000u); }
__device__ __forceinline__ float wave_sum(float v) {
#pragma unroll
    for (int o = 32; o >= 1; o >>= 1) v += __shfl_xor(v, o);
    return v;
}
__device__ __forceinline__ float xmax16(float v) { const unsigned u = __float_as_uint(v); const auto r = __builtin_amdgcn_permlane16_swap(u, u, false, false); return fmaxf(__uint_as_float(r[0]), __uint_as_float(r[1])); }
__device__ __forceinline__ float xmax32(float v) { const unsigned u = __float_as_uint(v); const auto r = __builtin_amdgcn_permlane32_swap(u, u, false, false); return fmaxf(__uint_as_float(r[0]), __uint_as_float(r[1])); }
__device__ __forceinline__ float xsum16(float v) { const unsigned u = __float_as_uint(v); const auto r = __builtin_amdgcn_permlane16_swap(u, u, false, false); return __uint_as_float(r[0]) + __uint_as_float(r[1]); }
__device__ __forceinline__ float xsum32(float v) { const unsigned u = __float_as_uint(v); const auto r = __builtin_amdgcn_permlane32_swap(u, u, false, false); return __uint_as_float(r[0]) + __uint_as_float(r[1]); }
__device__ __forceinline__ float silu_f(float v) { return v * __builtin_amdgcn_rcpf(1.0f + __builtin_amdgcn_exp2f(-1.4426950408889634f * v)); }
__device__ __forceinline__ f32x4 mfma16(bf16x8 a, bf16x8 b, f32x4 c) { return __builtin_amdgcn_mfma_f32_16x16x32_bf16(a, b, c, 0, 0, 0); }

#define LAS __attribute__((address_space(3)))
#define XB_TMO      128
#define XB_XCNT(j)  (256  + 64 * (j))
#define XB_XSUB(j)  (1280 + 64 * (j))
#define XB_XGEN(j)  (2304 + 64 * (j))
#define XB_TOP      3328
#define XB_TOPGEN   3392
#define XCD_BAR_WORDS 3456
#define XB_SPIN_CAP (1u << 18)

__device__ __forceinline__ unsigned xb_ld(unsigned* p)              { return __hip_atomic_load(p, __ATOMIC_RELAXED, __HIP_MEMORY_SCOPE_AGENT); }
__device__ __forceinline__ unsigned xb_add(unsigned* p, unsigned v) { return __hip_atomic_fetch_add(p, v, __ATOMIC_RELAXED, __HIP_MEMORY_SCOPE_AGENT); }
__device__ __forceinline__ unsigned xb_xcc_id() { return (unsigned)__builtin_amdgcn_s_getreg((3 << 11) | 20) & 0xFu; }
#define XB_SPIN(cond, bar) do { unsigned _sp = 0; while (cond) { __builtin_amdgcn_s_sleep(1); \
    if ((++_sp & 255u) == 0u) { if (xb_ld(&(bar)[XB_TMO])) break; if (_sp > XB_SPIN_CAP) { atomicAdd(&(bar)[XB_TMO], 1u); break; } } } } while (0)

struct XcdBarrier {
    unsigned* bar; unsigned x;
    volatile LAS unsigned* st;
};

__device__ __forceinline__ XcdBarrier xcd_barrier_post(unsigned* bar, volatile LAS unsigned* st) {
    XcdBarrier b; b.bar = bar; b.x = xb_xcc_id(); b.st = st;
    if (threadIdx.x == 0) (void)xb_add(&bar[XB_XCNT(b.x)], 1u);
    return b;
}
__device__ __forceinline__ void xcd_barrier_complete(unsigned* bar, unsigned x, unsigned& nloc, unsigned& nx) {
    const unsigned G = gridDim.x * gridDim.y * gridDim.z;
    unsigned sum, cnt, mine, sp = 0u;
    for (;;) {
        sum = 0u; cnt = 0u; mine = 0u;
#pragma unroll
        for (unsigned j = 0; j < 16; ++j) { const unsigned c = xb_ld(&bar[XB_XCNT(j)]); sum += c; cnt += (c > 0u) ? 1u : 0u; mine = (j == x) ? c : mine; }
        if (sum == G) break;
        __builtin_amdgcn_s_sleep(1);
        if ((++sp & 255u) == 0u) { if (xb_ld(&bar[XB_TMO])) break; if (sp > XB_SPIN_CAP) { atomicAdd(&bar[XB_TMO], 1u); break; } }
    }
    nloc = mine > 0u ? mine : 1u; nx = cnt > 0u ? cnt : 1u;
}

__device__ __forceinline__ void xcd_barrier(const XcdBarrier& b) {
    asm volatile("s_waitcnt vmcnt(0)" ::: "memory");
    __syncthreads();
    if (threadIdx.x == 0) {
        unsigned* bar = b.bar;
        __builtin_amdgcn_s_waitcnt(0);
        unsigned nloc = b.st[0], nx = b.st[1];
        if (nloc == 0u) { xcd_barrier_complete(bar, b.x, nloc, nx); b.st[0] = nloc; b.st[1] = nx; }
        const unsigned old = xb_add(&bar[XB_XSUB(b.x)], 1u);
        const unsigned gen = old / nloc;
        if (old + 1u == (gen + 1u) * nloc) {
            __builtin_amdgcn_fence(__ATOMIC_RELEASE, "agent");
            asm volatile("s_waitcnt vmcnt(0)" ::: "memory");
            const unsigned og = xb_add(&bar[XB_TOP], 1u);
            const unsigned tg = og / nx;
            if (og + 1u == (tg + 1u) * nx) xb_add(&bar[XB_TOPGEN], 1u);
            else XB_SPIN(xb_ld(&bar[XB_TOPGEN]) == tg, bar);
            __builtin_amdgcn_fence(__ATOMIC_ACQUIRE, "agent");
            xb_add(&bar[XB_XGEN(b.x)], 1u);
            asm volatile("s_waitcnt vmcnt(0)" ::: "memory");
        } else {
            XB_SPIN(xb_ld(&bar[XB_XGEN(b.x)]) == gen, bar);
            __builtin_amdgcn_fence(__ATOMIC_ACQUIRE, "agent");
            asm volatile("s_waitcnt vmcnt(0)" ::: "memory");
        }
    }
    __syncthreads();
}

typedef const f32x4 (&AccRef)[2][2][4][2];
__device__ __forceinline__ u32x4 pack8(const f32x4& a, const f32x4& b) { u32x4 w; w.x = pk2(a[0], a[1]); w.y = pk2(a[2], a[3]); w.z = pk2(b[0], b[1]); w.w = pk2(b[2], b[3]); return w; }
struct EpiGU {
    static constexpr bool PERM = true, AFTER_DRAIN = false;
    bf16_t* O; int ldo;
    __device__ __forceinline__ void operator()(AccRef acc, const pg8::Unit& u, int wr, int wc, int fr, int fq) const {
#pragma unroll
        for (int ai = 0; ai < 2; ++ai)
#pragma unroll
            for (int m = 0; m < 4; ++m) {
                const int row = u.pm * 256 + ai * 128 + wr * 64 + m * 16 + fr;
                const int col = u.pn * 128 + wc * 32 + fq * 8;
                f32x4 v0, v1;
#pragma unroll
                for (int j = 0; j < 4; ++j) { v0[j] = silu_f(acc[ai][0][m][0][j]) * acc[ai][1][m][0][j]; v1[j] = silu_f(acc[ai][0][m][1][j]) * acc[ai][1][m][1][j]; }
                *(u32x4*)(O + (size_t)row * ldo + col) = pack8(v0, v1);
            }
    }
};
struct EpiF32 {
    static constexpr bool PERM = true, AFTER_DRAIN = false;
    float* O; int ldo;
    __device__ __forceinline__ void operator()(AccRef acc, const pg8::Unit& u, int wr, int wc, int fr, int fq) const {
#pragma unroll
        for (int ai = 0; ai < 2; ++ai)
#pragma unroll
            for (int m = 0; m < 4; ++m) {
                const int row = u.pm * 256 + ai * 128 + wr * 64 + m * 16 + fr;
#pragma unroll
                for (int bj = 0; bj < 2; ++bj) {
                    const int col = u.pn * 256 + bj * 128 + wc * 32 + fq * 8;
                    float* p = O + (size_t)row * ldo + col;
                    *(f32x4*)p = acc[ai][bj][m][0]; *(f32x4*)(p + 4) = acc[ai][bj][m][1];
                }
            }
    }
};
struct EpiBf16 {
    static constexpr bool PERM = true, AFTER_DRAIN = false;
    bf16_t* O; int ldo;
    __device__ __forceinline__ void operator()(AccRef acc, const pg8::Unit& u, int wr, int wc, int fr, int fq) const {
#pragma unroll
        for (int ai = 0; ai < 2; ++ai)
#pragma unroll
            for (int m = 0; m < 4; ++m) {
                const int row = u.pm * 256 + ai * 128 + wr * 64 + m * 16 + fr;
#pragma unroll
                for (int bj = 0; bj < 2; ++bj) {
                    const int col = u.pn * 256 + bj * 128 + wc * 32 + fq * 8;
                    *(u32x4*)(O + (size_t)row * ldo + col) = pack8(acc[ai][bj][m][0], acc[ai][bj][m][1]);
                }
            }
    }
};
struct EpiQ {
    static constexpr bool PERM = false, AFTER_DRAIN = false;
    bf16_t* Q; const float* rc; const float* rs;
    __device__ __forceinline__ void operator()(AccRef acc, const pg8::Unit& u, int wr, int wc, int fr, int fq) const {
#pragma unroll
        for (int ai = 0; ai < 2; ++ai)
#pragma unroll
            for (int m = 0; m < 4; ++m) {
                const int row = u.pm * 256 + ai * 128 + wr * 64 + m * 16 + fr;
                const int b = row / T, t = row - b * T;
#pragma unroll
                for (int bj = 0; bj < 2; ++bj) {
                    const int g32 = u.pn * 8 + bj * 4 + wc, head = g32 / 3, part = g32 - head * 3;
                    bf16_t* base = Q + ((size_t)(b * 8 + head) * T + t) * 96;
                    f32x4 x1 = acc[ai][bj][m][0], x2 = acc[ai][bj][m][1];
                    int d0;
                    if (part < 2) { d0 = part * 32 + fq * 4; }
                    else {
                        d0 = 64 + fq * 4;
                        if (t >= CTX) {
                            const int s = t - CTX;
                            const f32x4 cs = *(const f32x4*)(rc + s * 16 + fq * 4), sn = *(const f32x4*)(rs + s * 16 + fq * 4);
                            const f32x4 o1 = x1 * cs - x2 * sn, o2 = x2 * cs + x1 * sn; x1 = o1; x2 = o2;
                        }
                    }
                    x1 = x1 * QSCALE; x2 = x2 * QSCALE;
                    u32x2 w1, w2; w1.x = pk2(x1[0], x1[1]); w1.y = pk2(x1[2], x1[3]); w2.x = pk2(x2[0], x2[1]); w2.y = pk2(x2[2], x2[3]);
                    *(u32x2*)(base + d0) = w1; *(u32x2*)(base + d0 + 16) = w2;
                }
            }
    }
};
struct EpiK {
    static constexpr bool PERM = true, AFTER_DRAIN = false;
    bf16_t* K;
    __device__ __forceinline__ void operator()(AccRef acc, const pg8::Unit& u, int wr, int wc, int fr, int fq) const {
#pragma unroll
        for (int ai = 0; ai < 2; ++ai)
#pragma unroll
            for (int m = 0; m < 4; ++m) {
                const int row = u.pm * 256 + ai * 128 + wr * 64 + m * 16 + fr;
                const int b = row / T, t = row - b * T;
#pragma unroll
                for (int bj = 0; bj < 2; ++bj) {
                    const int col = u.pn * 256 + bj * 128 + wc * 32 + fq * 8, head = col >> 6, d = col & 63;
                    *(u32x4*)(K + ((size_t)(b * 8 + head) * T + t) * 96 + d) = pack8(acc[ai][bj][m][0], acc[ai][bj][m][1]);
                }
            }
    }
};

struct PanelOrder {
    int c, latent_only;
    __device__ __forceinline__ bool next(int i, pg8::Unit& u) const {
        const int x = c & 7, kq = c >> 3;
        if (i == 0) { const int p = (kq >> 2) * 8 + x; u.pm = latent_only ? (p >> 3) * 9 + 1 + (p & 7) : p; u.pn = kq & 3; return true; }
        if (i == 1 && !latent_only && c < 32) { u.pm = 64 + x; u.pn = kq; return true; }
        return false;
    }
    __device__ __forceinline__ void a_ready(const pg8::Unit&) const {}
    __device__ __forceinline__ void done(const pg8::Unit&) const {}
};
constexpr int EX_RED = 131072, EX_FIN = EX_RED + 4 * 256 * 16;
static_assert(EX_FIN + 256 * 8 <= LDS_BYTES - 16, "exchange scratch fits");
struct EpiResNorm {
    static constexpr bool PERM = true, AFTER_DRAIN = false;
    float* X; bf16_t* H; float* out;
    const float* gate_base; const float* gpost; float post_w;
    const float* shift_base; const float* gpre;
    float* slots; unsigned* cnt; unsigned char* lds;
    __device__ __forceinline__ void operator()(AccRef acc, const pg8::Unit& u, int wr, int wc, int fr_, int fq_) const {
        int fr = fr_, fq = fq_; asm volatile("" : "+v"(fr), "+v"(fq));
        const int mr = (u.pm % 9 == 0) ? 8 : u.pm / 9;
        const float* gate = gate_base + (size_t)mr * 9216;
        float* red = (float*)(lds + EX_RED); float* fin = (float*)(lds + EX_FIN);
        const int colb = u.pn * 256 + wc * 32 + fq * 8, tid = (wr * 4 + wc) * 64 + fq * 16 + fr;
        f32x4 av[2][2];
#pragma unroll
        for (int bj = 0; bj < 2; ++bj)
#pragma unroll
            for (int n = 0; n < 2; ++n) { const int c = colb + bj * 128 + n * 4; av[bj][n] = (*(const f32x4*)(gate + c)) * (*(const f32x4*)(gpost + c)) * post_w; }
#pragma unroll
        for (int ai = 0; ai < 2; ++ai)
#pragma unroll
            for (int m = 0; m < 4; ++m) {
                const int lrow = ai * 128 + wr * 64 + m * 16 + fr; const size_t row = (size_t)u.pm * 256 + lrow;
                float s1 = 0.f, s2 = 0.f, s3 = 0.f, s4 = 0.f;
                int colv = colb; asm volatile("" : "+v"(colv));
#pragma unroll
                for (int bj = 0; bj < 2; ++bj)
#pragma unroll
                    for (int n = 0; n < 2; ++n) {
                        const int c = colv + bj * 128 + n * 4;
                        const f32x4 y = acc[ai][bj][m][n], x = *(const f32x4*)(X + row * 1024 + c);
                        const f32x4 ay = av[bj][n] * y;
#pragma unroll
                        for (int j = 0; j < 4; ++j) { s1 += y[j] * y[j]; s2 += x[j] * x[j]; s3 += x[j] * ay[j]; s4 += ay[j] * ay[j]; }
                    }
                s1 = xsum32(xsum16(s1)); s2 = xsum32(xsum16(s2)); s3 = xsum32(xsum16(s3)); s4 = xsum32(xsum16(s4));
                if (fq == 0) *(f32x4*)(red + (wc * 256 + lrow) * 4) = (f32x4){s1, s2, s3, s4};
            }
        __syncthreads();
#pragma unroll 1
        for (int rex = 0; rex < 1 + ((PROBE_MASK >> 22) & 1); ++rex) {
        if (tid < 256) {
            f32x4 t = *(const f32x4*)(red + tid * 4);
#pragma unroll
            for (int w = 1; w < 4; ++w) t = t + *(const f32x4*)(red + (w * 256 + tid) * 4);
            float* sl = slots + ((size_t)(u.pm * 4 + u.pn) * 256 + tid) * 4;
#pragma unroll
            for (int q = 0; q < 4; ++q) __hip_atomic_store(sl + q, t[q], __ATOMIC_RELAXED, __HIP_MEMORY_SCOPE_AGENT);
        }
        asm volatile("s_waitcnt vmcnt(0)" ::: "memory");
        __syncthreads();
        if (tid == 0) {
            __hip_atomic_fetch_add(cnt + u.pm, 1u, __ATOMIC_RELAXED, __HIP_MEMORY_SCOPE_AGENT);
            unsigned sp = 0;
            while (__hip_atomic_load(cnt + u.pm, __ATOMIC_RELAXED, __HIP_MEMORY_SCOPE_AGENT) < 4u * (rex + 1)) { __builtin_amdgcn_s_sleep(1); if (++sp > (1u << 20)) break; }
        }
        __syncthreads();
        if (tid < 256) {
            float t[4] = {0.f, 0.f, 0.f, 0.f};
#pragma unroll
            for (int pn2 = 0; pn2 < 4; ++pn2)
#pragma unroll
                for (int q = 0; q < 4; ++q) t[q] += __hip_atomic_load(slots + ((size_t)(u.pm * 4 + pn2) * 256 + tid) * 4 + q, __ATOMIC_RELAXED, __HIP_MEMORY_SCOPE_AGENT);
            const float ry = rsqrtf(t[0] * (1.0f / 1024.0f) + EPS);
            const float ssx = t[1] + 2.0f * ry * t[2] + ry * ry * t[3];
            fin[tid * 2] = ry; fin[tid * 2 + 1] = rsqrtf(fmaxf(ssx, 0.f) * (1.0f / 1024.0f) + EPS);
        }
        __syncthreads();
        }
        const float* shift = shift_base + (size_t)mr * 9216; const float* scale = shift + 1024;
        f32x4 g2[2][2], sh[2][2];
#pragma unroll
        for (int bj = 0; bj < 2; ++bj)
#pragma unroll
            for (int n = 0; n < 2; ++n) {
                const int c = colb + bj * 128 + n * 4;
                if (!out) { g2[bj][n] = (*(const f32x4*)(gpre + c)) * (*(const f32x4*)(scale + c) + 1.0f); sh[bj][n] = *(const f32x4*)(shift + c); }
                else { g2[bj][n] = (f32x4){0.f, 0.f, 0.f, 0.f}; sh[bj][n] = g2[bj][n]; }
            }
#pragma unroll
        for (int ai = 0; ai < 2; ++ai)
#pragma unroll
            for (int m = 0; m < 4; ++m) {
                const int lrow = ai * 128 + wr * 64 + m * 16 + fr; const size_t row = (size_t)u.pm * 256 + lrow;
                const float ry = fin[lrow * 2], rx = fin[lrow * 2 + 1];
                const int b = u.pm / 9, t = (u.pm - b * 9) * 256 + lrow;
                int colv = colb; asm volatile("" : "+v"(colv));
#pragma unroll
                for (int bj = 0; bj < 2; ++bj) {
                    f32x4 hv[2];
#pragma unroll
                    for (int n = 0; n < 2; ++n) {
                        const int c = colv + bj * 128 + n * 4;
                        const f32x4 y = acc[ai][bj][m][n], x = *(const f32x4*)(X + row * 1024 + c);
                        const f32x4 xn = x + av[bj][n] * y * ry;
                        if (out) { if (t >= CTX) *(f32x4*)(out + ((size_t)b * SEQ + (t - CTX)) * 1024 + c) = xn; }
                        else {
                            *(f32x4*)(X + row * 1024 + c) = xn;
                            hv[n] = (xn * rx) * g2[bj][n] + sh[bj][n];
                        }
                    }
                    if (!out) *(u32x4*)(H + row * 1024 + colv + bj * 128) = pack8(hv[0], hv[1]);
                }
            }
        __syncthreads();
    }
};

struct Ctx {
    const float* const* in; unsigned char* ws; float* out;
};
#define WSP(T_, off) ((T_*)(a.ws + (off)))

__device__ __forceinline__ void phase_mod(const Args& a, unsigned char* lds) {
    const int tid = otid();
    float* sl = (float*)lds;
    float* red = sl + 9 * 1024;
    const float* cvec = a.in[1]; const float* cctx = a.in[3];
    for (int i = tid; i < 9 * 1024; i += 512) { const int r = i >> 10, k = i & 1023; const float v = r < 8 ? cvec[r * 1024 + k] : cctx[k]; sl[i] = v / (1.0f + expf(-v)); }
    __syncthreads();
    const float* wada = a.in[4]; const float* bada = a.in[5];
    float* mod = WSP(float, WS_MOD);
    const int c4 = (tid & 15) * 4, kg = tid >> 4;
    for (int item = blockIdx.x; item < DEPTH * 144; item += gridDim.x) {
        const int l = item / 144, j0 = (item - l * 144) * 64;
        f32x4 acc[9];
#pragma unroll
        for (int r = 0; r < 9; ++r) acc[r] = (f32x4){0.f, 0.f, 0.f, 0.f};
        const float* w = wada + ((size_t)l * 1024 + kg * 32) * 9216 + j0 + c4;
        const float* s = sl + kg * 32;
#pragma unroll 16
        for (int kk = 0; kk < 32; ++kk) {
            const f32x4 wv = *(const f32x4*)(w + (size_t)kk * 9216);
#pragma unroll
            for (int r = 0; r < 9; ++r) acc[r] = acc[r] + wv * s[r * 1024 + kk];
        }
#pragma unroll
        for (int r = 0; r < 9; ++r) *(f32x4*)(red + (kg * 9 + r) * 64 + c4) = acc[r];
        __syncthreads();
        for (int i = tid; i < 576; i += 512) {
            const int r = i >> 6, cc = i & 63; float v = 0.f;
#pragma unroll
            for (int g = 0; g < 32; ++g) v += red[(g * 9 + r) * 64 + cc];
            mod[((size_t)l * 9 + r) * 9216 + j0 + cc] = v + bada[l * 9216 + j0 + cc];
        }
        __syncthreads();
    }
    float* rc = WSP(float, WS_ROPE); float* rs = rc + SEQ * 16;
    for (int i = blockIdx.x * 512 + tid; i < SEQ * 16; i += gridDim.x * 512) {
        const int s = i >> 4, k = i & 15, pos = (k < 8) ? (s >> 6) : (s & 63), j = k & 7;
        const float invf = exp2f(-(float)j * 0.125f * 13.287712379549449f);
        const float ang = (float)pos * invf;
        rc[i] = __cosf(ang); rs[i] = __sinf(ang);
    }
}

__device__ __forceinline__ void transpose_item(const float* src, int ld, int K, int col0, int ncols, bf16_t* dst, int dst_row0, int mode, unsigned char* lds) {
    float* tile = (float*)lds;
    const int tid = otid();
    const int kr = tid >> 4, c4 = (tid & 15) * 4;
    const int n = tid >> 3, k8 = (tid & 7) * 8;
    const int c = col0 + n;
    int drow;
    if (mode == 0) drow = dst_row0 + n; else drow = (c >> 7) * 256 + (c & 127) + (mode == 2 ? 128 : 0);
    for (int k0 = 0; k0 < K; k0 += 64) {
#pragma unroll
        for (int rr = 0; rr < 2; ++rr) {
            const int k = kr + 32 * rr, col = col0 + c4;
            f32x4 v = {0.f, 0.f, 0.f, 0.f};
            if (col < ncols) v = *(const f32x4*)(src + (size_t)(k0 + k) * ld + col);
            float* tp = tile + k * 65 + c4; tp[0] = v[0]; tp[1] = v[1]; tp[2] = v[2]; tp[3] = v[3];
        }
        __syncthreads();
        float f[8];
#pragma unroll
        for (int i = 0; i < 8; ++i) f[i] = tile[(k8 + i) * 65 + n];
        u32x4 w; w.x = pk2(f[0], f[1]); w.y = pk2(f[2], f[3]); w.z = pk2(f[4], f[5]); w.w = pk2(f[6], f[7]);
        *(u32x4*)(dst + (size_t)drow * K + k0 + k8) = w;
        __syncthreads();
    }
}
__device__ __forceinline__ void phase_transpose(const Args& a, int l, unsigned char* lds, int item_lo, int item_hi, int wg_first) {
    unsigned char* wt = a.ws + WS_WT;
    if ((int)blockIdx.x < wg_first) return;
    for (int item = item_lo + ((int)blockIdx.x - wg_first); item < item_hi; item += (int)gridDim.x - wg_first) {
        if (item < 176) {
            const int job = item / 44, tl = item - job * 44, f = job >> 1, up = job & 1;
            const float* src = (up ? a.in[9] : a.in[8]) + (size_t)(l * 2 + f) * D * DFF;
            transpose_item(src, DFF, D, tl * 64, DFF, (bf16_t*)(wt + (f ? WT_GU1 : WT_GU0)), 0, up ? 2 : 1, lds);
        } else if (item < 208) {
            const int it = item - 176, f = it >> 4, tl = it & 15;
            transpose_item(a.in[10] + (size_t)(l * 2 + f) * DFF * D, D, DFF, tl * 64, D, (bf16_t*)(wt + (f ? WT_DN1 : WT_DN0)), tl * 64, 0, lds);
        } else if (item < 252) {
            const int tl = item - 208;
            transpose_item(a.in[11] + (size_t)l * D * IN_COLS, IN_COLS, D, tl * 64, IN_COLS, (bf16_t*)(wt + WT_WIN), tl * 64, 0, lds);
        } else if (item < 264) {
            const int tl = item - 252;
            transpose_item(a.in[18] + (size_t)l * 384 * 768, 768, 384, tl * 64, 768, (bf16_t*)(wt + WT_WUQ), tl * 64, 0, lds);
        } else if (item < 280) {
            const int it = item - 264, v = it >> 3, hh = it & 7;
            transpose_item(a.in[19] + (size_t)l * 256 * 1024, 1024, 256, hh * 128 + v * 64, 1024, (bf16_t*)(wt + (v ? WT_WV : WT_WK)), hh * 64, 0, lds);
        } else {
            const int tl = item - 280;
            transpose_item(a.in[20] + (size_t)l * D * D, D, D, tl * 64, D, (bf16_t*)(wt + WT_WOUT), tl * 64, 0, lds);
        }
    }
}

struct RowCfg { int first, has_post, post_l, post_slot, has_pre, pre_l, pre_slot, final_; float post_w; };
__device__ __forceinline__ void phase_rowpass(const Args& a, const RowCfg& c) {
    const int tid = otid(), lane = tid & 63, wv = tid >> 6;
    float* X = WSP(float, WS_X); const float* Y = WSP(float, WS_Y); bf16_t* H = WSP(bf16_t, WS_H);
    const float* mod = WSP(float, WS_MOD);
    const float* gpost = a.in[7] + (size_t)(c.post_l * 3 + c.post_slot) * D;
    const float* gpre = a.in[6] + (size_t)(c.pre_l * 3 + c.pre_slot) * D;
    for (int m = blockIdx.x * 8 + wv; m < M; m += gridDim.x * 8) {
        const int b = m / T, t = m - b * T, mr = (t < CTX) ? 8 : b;
        const float* src = c.first ? ((t < CTX) ? a.in[2] + ((size_t)b * CTX + t) * D : a.in[0] + ((size_t)b * SEQ + (t - CTX)) * D) : X + (size_t)m * D;
        f32x4 xv[4];
#pragma unroll
        for (int i = 0; i < 4; ++i) xv[i] = *(const f32x4*)(src + i * 256 + lane * 4);
        if (c.has_post) {
            f32x4 yv[4]; float ss = 0.f;
#pragma unroll
            for (int i = 0; i < 4; ++i) { yv[i] = *(const f32x4*)(Y + (size_t)m * D + i * 256 + lane * 4); ss += yv[i][0] * yv[i][0] + yv[i][1] * yv[i][1] + yv[i][2] * yv[i][2] + yv[i][3] * yv[i][3]; }
            ss = wave_sum(ss);
            const float r = rsqrtf(ss * (1.0f / 1024.0f) + EPS) * c.post_w;
            const float* gate = mod + ((size_t)(c.post_l * 9 + mr) * 9 + 3 * c.post_slot + 2) * D;
#pragma unroll
            for (int i = 0; i < 4; ++i) {
                const f32x4 gt = *(const f32x4*)(gate + i * 256 + lane * 4), gp = *(const f32x4*)(gpost + i * 256 + lane * 4);
                xv[i] = xv[i] + gt * (yv[i] * gp) * r;
            }
        }
        if (c.final_) {
            if (t >= CTX) {
                float* o = a.out + ((size_t)b * SEQ + (t - CTX)) * D;
#pragma unroll
                for (int i = 0; i < 4; ++i) *(f32x4*)(o + i * 256 + lane * 4) = xv[i];
            }
            continue;
        }
#pragma unroll
        for (int i = 0; i < 4; ++i) *(f32x4*)(X + (size_t)m * D + i * 256 + lane * 4) = xv[i];
        if (c.has_pre) {
            float ss = 0.f;
#pragma unroll
            for (int i = 0; i < 4; ++i) ss += xv[i][0] * xv[i][0] + xv[i][1] * xv[i][1] + xv[i][2] * xv[i][2] + xv[i][3] * xv[i][3];
            ss = wave_sum(ss);
            const float r = rsqrtf(ss * (1.0f / 1024.0f) + EPS);
            const float* shift = mod + ((size_t)(c.pre_l * 9 + mr) * 9 + 3 * c.pre_slot) * D; const float* scale = shift + D;
#pragma unroll
            for (int i = 0; i < 4; ++i) {
                const f32x4 sh = *(const f32x4*)(shift + i * 256 + lane * 4), sc = *(const f32x4*)(scale + i * 256 + lane * 4), gp = *(const f32x4*)(gpre + i * 256 + lane * 4);
                const f32x4 hv = (xv[i] * r * gp) * (sc + 1.0f) + sh;
                u32x2 w; w.x = pk2(hv[0], hv[1]); w.y = pk2(hv[2], hv[3]);
                *(u32x2*)(H + (size_t)m * D + i * 256 + lane * 4) = w;
            }
        }
    }
}

constexpr int C_RAW = 0, C_QN = 52224, C_KN = C_QN + 64 * 136 * 2, C_V = C_KN + 64 * 136 * 2, C_GS = C_V + 64 * 128 * 2, C_TMP = C_GS + 1536, C_ENDB = C_TMP + 64 * 128 * 4;
constexpr int C_KK = 0, C_QKR = 16384, C_AS = 32768;
static_assert(C_AS + 32768 <= C_KN && C_ENDB <= LDS_BYTES, "chunk LDS map");

__device__ __forceinline__ void chunk_item(const Args& a, int l, int item, unsigned char* lds) {
    const int tid = otid(), lane = tid & 63, wv = tid >> 6, quad = lane >> 4, l15 = lane & 15;
    const int n = item % NCH, h = (item / NCH) & 3, b = item / (NCH * 4);
    const int t0 = n * 64, seg_lo = (n < 4) ? 0 : CTX, seg_hi = (n < 4) ? CTX : T;
    const bf16_t* P = WSP(const bf16_t, WS_P);
    bf16_t* RAW = (bf16_t*)(lds + C_RAW); bf16_t* QNs = (bf16_t*)(lds + C_QN); bf16_t* KNs = (bf16_t*)(lds + C_KN); bf16_t* Vs = (bf16_t*)(lds + C_V);
    float* GS = (float*)(lds + C_GS); float* BS = GS + 128; float* BE = GS + 256; float* TMP = (float*)(lds + C_TMP);
    float* KK = (float*)(lds + C_KK); float* QKR = (float*)(lds + C_QKR); float* AS = (float*)(lds + C_AS);
    unsigned char* gb = a.ws + WS_G;
    float cwr[3][5];
    {
        const float* cw0 = a.in[12] + (size_t)l * 5 * 1536 + h * 128 + (tid & 127);
#pragma unroll
        for (int part = 0; part < 3; ++part)
#pragma unroll
            for (int j = 0; j < 5; ++j) cwr[part][j] = cw0[j * 1536 + part * 512];
    }
#pragma unroll 1
    for (int rep15 = 0; rep15 < 1 + ((PROBE_MASK >> 18) & 1); ++rep15) {
    for (int idx = tid; idx < 68 * 48; idx += 512) {
        const int rr = idx / 48, ch = idx - rr * 48, part = ch >> 4, c8 = (ch & 15) * 8, tt = t0 - 2 + rr;
        u32x4 v = {0u, 0u, 0u, 0u};
        if (tt >= seg_lo && tt < seg_hi) v = *(const u32x4*)(P + ((size_t)b * T + tt) * PC + part * 512 + h * 128 + c8);
        *(u32x4*)(RAW + rr * 384 + part * 128 + c8) = v;
    }
    if (wv < 2) {
        const int d = wv, i = lane;
        const bf16_t* pr = P + ((size_t)b * T + t0 + i) * PC;
        const float av = bf2f(pr[OFF_A + d * 4 + h]), bv = bf2f(pr[OFF_B + d * 4 + h]);
        const float alog = a.in[13][(l * 2 + d) * 4 + h], dtb = a.in[14][(l * 2 + d) * 4 + h];
        const float xs = av + dtb;
        const float sp = fmaxf(xs, 0.f) + log1pf(expf(-fabsf(xs)));
        float g = -expf(alog) * sp;
        if (d == 0) {
#pragma unroll
            for (int o = 1; o < 64; o <<= 1) { const float u = __shfl_up(g, o); if (lane >= o) g += u; }
        } else {
#pragma unroll
            for (int o = 1; o < 64; o <<= 1) { const float u = __shfl_down(g, o); if (lane + o < 64) g += u; }
        }
        const float beta = 1.0f / (1.0f + expf(-bv));
        GS[d * 64 + i] = g; BS[d * 64 + i] = beta; BE[d * 64 + i] = beta * expf(g);
        const size_t ci = ((size_t)(d * NB + b) * 4 + h) * NCH + n;
        ((float*)(gb + G_GG))[ci * 64 + i] = g;
    }
    __syncthreads();
    {
        const int c = tid & 127, rg = tid >> 7;
#pragma unroll
        for (int part = 0; part < 3; ++part) {
            float w[5];
#pragma unroll
            for (int j = 0; j < 5; ++j) w[j] = cwr[part][j];
            float win[20];
#pragma unroll
            for (int r = 0; r < 20; ++r) win[r] = bf2f(RAW[(rg * 16 + r) * 384 + part * 128 + c]);
#pragma unroll
            for (int i = 0; i < 16; ++i) {
                float s = 0.f;
#pragma unroll
                for (int j = 0; j < 5; ++j) s += w[j] * win[i + j];
                s = silu_f(s);
                if (part == 2) Vs[(rg * 16 + i) * 128 + c] = (bf16_t)f2bf(s); else TMP[(rg * 16 + i) * 128 + c] = s;
            }
            if (part < 2) {
                __syncthreads();
#pragma unroll
                for (int rr = 0; rr < 8; ++rr) {
                    const int row = wv * 8 + rr;
                    const float v0 = TMP[row * 128 + lane * 2], v1 = TMP[row * 128 + lane * 2 + 1];
                    const float ss = wave_sum(v0 * v0 + v1 * v1);
                    float r = rsqrtf(ss + EPS);
                    if (part == 0) {
                        r *= 0.08838834764831845f;
                        const unsigned w2 = pk2(v0 * r, v1 * r);
                        *(unsigned*)(QNs + row * 136 + lane * 2) = w2;
                        *(unsigned*)((bf16_t*)(gb + G_QN) + ((size_t)(b * 4 + h) * T + t0 + row) * 128 + lane * 2) = w2;
                    } else {
                        *(unsigned*)(KNs + row * 136 + lane * 2) = pk2(v0 * r, v1 * r);
                    }
                }
                __syncthreads();
            }
        }
    }
    __syncthreads();
    {
        bf16_t* KT = (bf16_t*)(gb + G_KT) + ((size_t)(b * 4 + h) * NCH + n) * 8192;
        for (int idx = tid; idx < 1024; idx += 512) {
            const int dk = idx >> 3, j8 = (idx & 7) * 8;
            unsigned short e[8];
#pragma unroll
            for (int q = 0; q < 8; ++q) e[q] = KNs[(j8 + q) * 136 + dk];
            u32x4 w; w.x = e[0] | ((unsigned)e[1] << 16); w.y = e[2] | ((unsigned)e[3] << 16); w.z = e[4] | ((unsigned)e[5] << 16); w.w = e[6] | ((unsigned)e[7] << 16);
            *(u32x4*)(KT + dk * 64 + j8) = w;
        }
        const int it = wv >> 1;
#pragma unroll
        for (int jj = 0; jj < 2; ++jj) {
            const int jt = (wv & 1) * 2 + jj;
            f32x4 ck = {0.f, 0.f, 0.f, 0.f}, cq = {0.f, 0.f, 0.f, 0.f};
#pragma unroll
            for (int ks = 0; ks < 4; ++ks) {
                const bf16x8 ka = *(const bf16x8*)(KNs + (it * 16 + l15) * 136 + ks * 32 + quad * 8);
                const bf16x8 qa = *(const bf16x8*)(QNs + (it * 16 + l15) * 136 + ks * 32 + quad * 8);
                const bf16x8 kb = *(const bf16x8*)(KNs + (jt * 16 + l15) * 136 + ks * 32 + quad * 8);
                ck = mfma16(ka, kb, ck); cq = mfma16(qa, kb, cq);
            }
#pragma unroll
            for (int r = 0; r < 4; ++r) { KK[(it * 16 + quad * 4 + r) * 64 + jt * 16 + l15] = ck[r]; QKR[(it * 16 + quad * 4 + r) * 64 + jt * 16 + l15] = cq[r]; }
        }
    }
    __syncthreads();
    for (int idx = tid; idx < 8192; idx += 512) {
        const int d = idx >> 12, i = (idx >> 6) & 63, j = idx & 63;
        const int ri = d ? 63 - i : i, rj = d ? 63 - j : j;
        const float gi = GS[d * 64 + i], gj = GS[d * 64 + j];
        const float e = (ri >= rj) ? __expf(gi - gj) : 0.f;
        AS[d * 4096 + ri * 64 + rj] = (ri > rj) ? BS[d * 64 + i] * KK[i * 64 + j] * e : 0.f;
        const size_t ci = ((size_t)(d * NB + b) * 4 + h) * NCH + n;
        ((bf16_t*)(gb + G_QK))[ci * 4096 + i * 64 + j] = (bf16_t)f2bf(QKR[i * 64 + j] * e);
    }
    __syncthreads();
    }
    bf16_t* Tm = (bf16_t*)(lds + C_KK);
    if (tid < 128) {
        const int d = tid >> 6, c = tid & 63;
        const float* As = AS + d * 4096;
        float sol[64];
#pragma unroll
        for (int r = 0; r < 64; ++r) {
            float pv[4] = {(r == c) ? 1.f : 0.f, 0.f, 0.f, 0.f};
#pragma unroll
            for (int rp = 0; rp < r; ++rp) pv[rp & 3] -= As[r * 64 + rp] * sol[rp];
            const float v = (pv[0] + pv[1]) + (pv[2] + pv[3]);
            sol[r] = v;
            Tm[d * 4608 + r * 72 + c] = (bf16_t)f2bf(v);
        }
    }
    {
        const int d = wv >> 2, cq = wv & 3;
        const size_t ci = ((size_t)(d * NB + b) * 4 + h) * NCH + n;
        bf16_t* U0 = (bf16_t*)(gb + G_U0) + ci * 8192; bf16_t* NW = (bf16_t*)(gb + G_NW) + ci * 8192;
        bf16x8 bfr[2][4];
#pragma unroll
        for (int ks = 0; ks < 2; ++ks)
#pragma unroll
            for (int ct = 0; ct < 4; ++ct) {
                const int cl = (cq & 1) * 64 + ct * 16 + l15;
                float f[8];
#pragma unroll
                for (int e = 0; e < 8; ++e) {
                    const int rp = ks * 32 + quad * 8 + e, j = d ? 63 - rp : rp;
                    f[e] = (cq < 2) ? BS[d * 64 + j] * bf2f(Vs[j * 128 + cl]) : BE[d * 64 + j] * bf2f(KNs[j * 136 + cl]);
                }
                u32x4 w; w.x = pk2(f[0], f[1]); w.y = pk2(f[2], f[3]); w.z = pk2(f[4], f[5]); w.w = pk2(f[6], f[7]);
                bfr[ks][ct] = __builtin_bit_cast(bf16x8, w);
            }
        __syncthreads();
        f32x4 acc[4][4];
#pragma unroll
        for (int it = 0; it < 4; ++it)
#pragma unroll
            for (int ct = 0; ct < 4; ++ct) acc[it][ct] = (f32x4){0.f, 0.f, 0.f, 0.f};
#pragma unroll
        for (int ks = 0; ks < 2; ++ks) {
            bf16x8 af[4];
#pragma unroll
            for (int it = 0; it < 4; ++it) af[it] = *(const bf16x8*)(Tm + d * 4608 + (it * 16 + l15) * 72 + ks * 32 + quad * 8);
#pragma unroll
            for (int ct = 0; ct < 4; ++ct)
#pragma unroll
                for (int it = 0; it < 4; ++it) acc[it][ct] = mfma16(bfr[ks][ct], af[it], acc[it][ct]);
        }
#pragma unroll
        for (int it = 0; it < 4; ++it)
#pragma unroll
            for (int ct = 0; ct < 4; ++ct)
                {
                    const int r = it * 16 + l15, i = d ? 63 - r : r, cl = (cq & 1) * 64 + ct * 16 + quad * 4;
                    const f32x4 v = acc[it][ct];
                    u32x2 w;
                    if (cq < 2) { w.x = pk2(v[0], v[1]); w.y = pk2(v[2], v[3]); *(u32x2*)(U0 + i * 128 + cl) = w; }
                    else { w.x = pk2(-v[0], -v[1]); w.y = pk2(-v[2], -v[3]); *(u32x2*)(NW + i * 128 + cl) = w; }
                }
    }
    __syncthreads();
}

__device__ __forceinline__ void token_rows(const Args& a, int l, int m) {
    const int lane = otid() & 63;
    const int b = m / T, t = m - b * T;
    const bf16_t* p = WSP(const bf16_t, WS_P) + (size_t)m * PC;
    unsigned char* mb = a.ws + WS_MLA;
    {
        const unsigned* src = (const unsigned*)(p + OFF_CQ + lane * 6);
        const unsigned w0 = src[0], w1 = src[1], w2 = src[2];
        float v[6] = {bflo(w0), bfhi(w0), bflo(w1), bfhi(w1), bflo(w2), bfhi(w2)};
        float ss = 0.f;
#pragma unroll
        for (int i = 0; i < 6; ++i) ss += v[i] * v[i];
        ss = wave_sum(ss);
        const float r = rsqrtf(ss * (1.0f / 384.0f) + EPS);
        const float* g = a.in[16] + l * 384 + lane * 6;
        unsigned* dst = (unsigned*)((bf16_t*)(mb + A_CQN) + (size_t)m * 384 + lane * 6);
        dst[0] = pk2(v[0] * r * g[0], v[1] * r * g[1]); dst[1] = pk2(v[2] * r * g[2], v[3] * r * g[3]); dst[2] = pk2(v[4] * r * g[4], v[5] * r * g[5]);
    }
    {
        const u32x2 w = *(const u32x2*)(p + OFF_CKV + lane * 4);
        float v[4] = {bflo(w.x), bfhi(w.x), bflo(w.y), bfhi(w.y)};
        float ss = v[0] * v[0] + v[1] * v[1] + v[2] * v[2] + v[3] * v[3];
        ss = wave_sum(ss);
        const float r = rsqrtf(ss * (1.0f / 256.0f) + EPS);
        const float* g = a.in[17] + l * 256 + lane * 4;
        u32x2 o; o.x = pk2(v[0] * r * g[0], v[1] * r * g[1]); o.y = pk2(v[2] * r * g[2], v[3] * r * g[3]);
        *(u32x2*)((bf16_t*)(mb + A_CKVN) + (size_t)m * 256 + lane * 4) = o;
    }
    if (lane < 16) {
        float x1 = bf2f(p[OFF_KR + lane]), x2 = bf2f(p[OFF_KR + 16 + lane]);
        if (t >= CTX) {
            const float* rc = WSP(const float, WS_ROPE); const float* rs = rc + SEQ * 16;
            const int s = t - CTX; const float cs = rc[s * 16 + lane], sn = rs[s * 16 + lane];
            const float o1 = x1 * cs - x2 * sn, o2 = x2 * cs + x1 * sn; x1 = o1; x2 = o2;
        }
        const bf16_t e1 = (bf16_t)f2bf(x1), e2 = (bf16_t)f2bf(x2);
        bf16_t* K = (bf16_t*)(mb + A_K);
#pragma unroll
        for (int hh = 0; hh < 8; ++hh) { bf16_t* kp = K + ((size_t)(b * 8 + hh) * T + t) * 96; kp[64 + lane] = e1; kp[80 + lane] = e2; }
    }
}
__device__ __forceinline__ void phase_m1(const Args& a, int l, unsigned char* lds) {
    for (int item = blockIdx.x; item < NB * 4 * NCH; item += gridDim.x) chunk_item(a, l, item, lds);
    const int wv = otid() >> 6;
    const int nshort = (int)gridDim.x - (NB * 4 * NCH) % (int)gridDim.x, first_short = (int)gridDim.x - nshort;
    if ((int)blockIdx.x >= first_short)
        for (int m = ((int)blockIdx.x - first_short) * 8 + wv; m < M; m += nshort * 8) token_rows(a, l, m);
}

constexpr int SC_NW = 0, SC_Q = SC_NW + 64 * 136 * 2, SC_KT = SC_Q + 64 * 136 * 2, SC_QK = SC_KT + 128 * 72 * 2, SC_U0 = SC_QK + 64 * 72 * 2, SC_GG = SC_U0 + 64 * 32 * 2, SC_IN = SC_GG + 256;
constexpr int SC_ST = 2 * SC_IN, SC_UT = SC_ST + 32 * 136 * 2, SC_UST = SC_UT + 32 * 72 * 2, SC_END = SC_UST + 32 * 72 * 2;
static_assert(SC_END <= LDS_BYTES, "scan LDS map");

struct ScRegs { u32x4 nw0, nw1, q0, q1, k0, k1, qk, u0, g; };
struct ScIdx { int tid, d, b, h, s4; };
__device__ __forceinline__ int sc_chunk(int d, int e) { return (d == 0) ? e : (e < 4 ? 3 - e : 39 - e); }
__device__ __forceinline__ void sc_load(ScRegs& r, const unsigned char* gb, int n, const ScIdx& x) {
    const int tid = x.tid;
    const size_t ci = ((size_t)(x.d * NB + x.b) * 4 + x.h) * NCH + n;
    const u32x4* pNW = (const u32x4*)((const bf16_t*)(gb + G_NW) + ci * 8192); r.nw0 = pNW[tid]; r.nw1 = pNW[tid + 512];
    const u32x4* pQ = (const u32x4*)((const bf16_t*)(gb + G_QN) + ((size_t)(x.b * 4 + x.h) * T + n * 64) * 128); r.q0 = pQ[tid]; r.q1 = pQ[tid + 512];
    const u32x4* pK = (const u32x4*)((const bf16_t*)(gb + G_KT) + ((size_t)(x.b * 4 + x.h) * NCH + n) * 8192); r.k0 = pK[tid]; r.k1 = pK[tid + 512];
    r.qk = ((const u32x4*)((const bf16_t*)(gb + G_QK) + ci * 4096))[tid];
    if (tid < 256) r.u0 = *(const u32x4*)((const bf16_t*)(gb + G_U0) + ci * 8192 + (tid >> 2) * 128 + x.s4 * 32 + (tid & 3) * 8);
    if (tid < 16) r.g = *(const u32x4*)((const float*)(gb + G_GG) + ci * 64 + tid * 4);
}
__device__ __forceinline__ void sc_store(const ScRegs& r, unsigned char* lds, int buf, int tid) {
    unsigned char* ib = lds + buf * SC_IN;
    *(u32x4*)((bf16_t*)(ib + SC_NW) + (tid >> 4) * 136 + (tid & 15) * 8) = r.nw0; *(u32x4*)((bf16_t*)(ib + SC_NW) + ((tid >> 4) + 32) * 136 + (tid & 15) * 8) = r.nw1;
    *(u32x4*)((bf16_t*)(ib + SC_Q) + (tid >> 4) * 136 + (tid & 15) * 8) = r.q0; *(u32x4*)((bf16_t*)(ib + SC_Q) + ((tid >> 4) + 32) * 136 + (tid & 15) * 8) = r.q1;
    *(u32x4*)((bf16_t*)(ib + SC_KT) + (tid >> 3) * 72 + (tid & 7) * 8) = r.k0; *(u32x4*)((bf16_t*)(ib + SC_KT) + ((tid >> 3) + 64) * 72 + (tid & 7) * 8) = r.k1;
    *(u32x4*)((bf16_t*)(ib + SC_QK) + (tid >> 3) * 72 + (tid & 7) * 8) = r.qk;
    if (tid < 256) *(u32x4*)((bf16_t*)(ib + SC_U0) + (tid >> 2) * 32 + (tid & 3) * 8) = r.u0;
    if (tid < 16) *(u32x4*)((float*)(ib + SC_GG) + tid * 4) = r.g;
}
__device__ __forceinline__ void sc_step(unsigned char* lds, int buf, int n, const ScIdx& x, float* Od, f32x4 (&Sacc)[2], const ScRegs& nxt, bool park) {
    const int tid = x.tid, lane = tid & 63, wv = tid >> 6, quad = lane >> 4, l15 = lane & 15, itile = wv >> 1, dvt = wv & 1;
    bf16_t* St = (bf16_t*)(lds + SC_ST); bf16_t* Ut = (bf16_t*)(lds + SC_UT); bf16_t* Ust = (bf16_t*)(lds + SC_UST);
    const unsigned char* ib = lds + buf * SC_IN;
    const bf16_t* NWs = (const bf16_t*)(ib + SC_NW); const bf16_t* Qs = (const bf16_t*)(ib + SC_Q); const bf16_t* KTs = (const bf16_t*)(ib + SC_KT);
    const bf16_t* QKs = (const bf16_t*)(ib + SC_QK); const bf16_t* U0s = (const bf16_t*)(ib + SC_U0); const float* Gs = (const float*)(ib + SC_GG);
    const float Glast = Gs[x.d ? 0 : 63];
    f32x4 U, QS = {0.f, 0.f, 0.f, 0.f};
#pragma unroll
    for (int r = 0; r < 4; ++r) U[r] = bf2f(U0s[(itile * 16 + quad * 4 + r) * 32 + dvt * 16 + l15]);
#pragma unroll
    for (int ks = 0; ks < 4; ++ks) {
        const bf16x8 bfr = *(const bf16x8*)(St + (dvt * 16 + l15) * 136 + ks * 32 + quad * 8);
        const bf16x8 a1 = *(const bf16x8*)(NWs + (itile * 16 + l15) * 136 + ks * 32 + quad * 8);
        const bf16x8 a2 = *(const bf16x8*)(Qs + (itile * 16 + l15) * 136 + ks * 32 + quad * 8);
        U = mfma16(a1, bfr, U); QS = mfma16(a2, bfr, QS);
    }
    {
        float us[4];
#pragma unroll
        for (int r = 0; r < 4; ++r) { const float gi = Gs[itile * 16 + quad * 4 + r]; QS[r] *= __expf(gi); us[r] = U[r] * __expf(Glast - gi); }
        u32x2 w1, w2; w1.x = pk2(U[0], U[1]); w1.y = pk2(U[2], U[3]); w2.x = pk2(us[0], us[1]); w2.y = pk2(us[2], us[3]);
        *(u32x2*)(Ut + (dvt * 16 + l15) * 72 + itile * 16 + quad * 4) = w1;
        *(u32x2*)(Ust + (dvt * 16 + l15) * 72 + itile * 16 + quad * 4) = w2;
    }
    __syncthreads();
#pragma unroll
    for (int ks = 0; ks < 2; ++ks) {
        const bf16x8 a1 = *(const bf16x8*)(QKs + (itile * 16 + l15) * 72 + ks * 32 + quad * 8);
        const bf16x8 b1 = *(const bf16x8*)(Ut + (dvt * 16 + l15) * 72 + ks * 32 + quad * 8);
        QS = mfma16(a1, b1, QS);
    }
#pragma unroll
    for (int r = 0; r < 4; ++r) Od[((size_t)x.b * T + n * 64 + itile * 16 + quad * 4 + r) * 512 + x.h * 128 + x.s4 * 32 + dvt * 16 + l15] = QS[r];
    const float cd = __expf(Glast);
#pragma unroll
    for (int v2 = 0; v2 < 2; ++v2) {
        Sacc[v2] = Sacc[v2] * cd;
#pragma unroll
        for (int ks = 0; ks < 2; ++ks) {
            const bf16x8 a1 = *(const bf16x8*)(KTs + (wv * 16 + l15) * 72 + ks * 32 + quad * 8);
            const bf16x8 b1 = *(const bf16x8*)(Ust + (v2 * 16 + l15) * 72 + ks * 32 + quad * 8);
            Sacc[v2] = mfma16(a1, b1, Sacc[v2]);
        }
        u32x2 w; w.x = pk2(Sacc[v2][0], Sacc[v2][1]); w.y = pk2(Sacc[v2][2], Sacc[v2][3]);
        *(u32x2*)(St + (v2 * 16 + l15) * 136 + wv * 16 + quad * 4) = w;
    }
    if (park) sc_store(nxt, lds, buf ^ 1, tid);
    __syncthreads();
}
__device__ __forceinline__ void phase_scan(const Args& a, unsigned char* lds) {
    const int tid = otid();
    const unsigned char* gb = a.ws + WS_G;
    float* Obase = WSP(float, WS_O);
    for (int item = blockIdx.x; item < 256; item += gridDim.x) {
        const int xc = item & 7, jj = item >> 3, seq = xc * 8 + (jj >> 2);
        ScIdx x; x.tid = tid; x.s4 = jj & 3; x.h = seq & 3; x.b = (seq >> 2) & 7; x.d = seq >> 5;
        float* Od = Obase + (size_t)x.d * M * 512;
        for (int i = tid; i < 32 * 136 / 2; i += 512) ((unsigned*)(lds + SC_ST))[i] = 0u;
        f32x4 Sacc[2]; Sacc[0] = (f32x4){0.f, 0.f, 0.f, 0.f}; Sacc[1] = Sacc[0];
        ScRegs ra, rb; ra.u0 = (u32x4){0u, 0u, 0u, 0u}; ra.g = ra.u0; rb.u0 = ra.u0; rb.g = ra.u0;
        sc_load(ra, gb, sc_chunk(x.d, 0), x); sc_load(rb, gb, sc_chunk(x.d, 1), x);
        sc_store(ra, lds, 0, tid);
        __syncthreads();
#pragma unroll 1
        for (int e = 0; e < NCH; e += 2) {
            if (e + 2 < NCH) sc_load(ra, gb, sc_chunk(x.d, e + 2), x);
            sc_step(lds, 0, sc_chunk(x.d, e), x, Od, Sacc, rb, true);
            if (e + 3 < NCH) sc_load(rb, gb, sc_chunk(x.d, e + 3), x);
            sc_step(lds, 1, sc_chunk(x.d, e + 1), x, Od, Sacc, ra, e + 2 < NCH);
        }
    }
}

constexpr int AT_K = 64 * 104 * 2, AT_V = 64 * 72 * 2, AT_BUF = AT_K + AT_V;
struct AtRegs { u32x4 k0, k1, v; };
struct AtIdx { int tid, kr0, kc0, kr1, kc1; };
__device__ __forceinline__ void at_load(AtRegs& r, const bf16_t* Kg, const bf16_t* Vg, int kt, const AtIdx& x) {
    r.k0 = *(const u32x4*)(Kg + (size_t)(kt * 64 + x.kr0) * 96 + x.kc0 * 8);
    if (x.tid < 256) r.k1 = *(const u32x4*)(Kg + (size_t)(kt * 64 + x.kr1) * 96 + x.kc1 * 8);
    r.v = *(const u32x4*)(Vg + (size_t)(x.tid >> 3) * M + kt * 64 + (x.tid & 7) * 8);
}
__device__ __forceinline__ void at_store(const AtRegs& r, unsigned char* lds, int buf, const AtIdx& x) {
    bf16_t* kb = (bf16_t*)(lds + buf * AT_BUF); bf16_t* vb = (bf16_t*)(lds + buf * AT_BUF + AT_K);
    *(u32x4*)(kb + x.kr0 * 104 + x.kc0 * 8) = r.k0;
    if (x.tid < 256) *(u32x4*)(kb + x.kr1 * 104 + x.kc1 * 8) = r.k1;
    *(u32x4*)(vb + (x.tid >> 3) * 72 + (x.tid & 7) * 8) = r.v;
}
__device__ __forceinline__ void attn_tile(const bf16_t* Kb, const bf16_t* Vb, bool first, const bf16x8 (&qf)[2][3], f32x4 (&o)[2][4], f32x4 (&lacc)[2], float (&mrun)[2], int l15, int quad) {
    const bf16x8 ones = {0x3F80, 0x3F80, 0x3F80, 0x3F80, 0x3F80, 0x3F80, 0x3F80, 0x3F80};
    f32x4 s[2][4];
#pragma unroll
    for (int g = 0; g < 2; ++g)
#pragma unroll
        for (int kk = 0; kk < 4; ++kk) { const float nm = -mrun[g]; s[g][kk] = (f32x4){nm, nm, nm, nm}; }
#pragma unroll
    for (int kk = 0; kk < 4; ++kk)
#pragma unroll
        for (int ks = 0; ks < 3; ++ks) {
            const bf16x8 kf = *(const bf16x8*)(Kb + (kk * 16 + l15) * 104 + ks * 32 + quad * 8);
            s[0][kk] = mfma16(kf, qf[0][ks], s[0][kk]); s[1][kk] = mfma16(kf, qf[1][ks], s[1][kk]);
        }
    bf16x8 pf[2][2];
#pragma unroll
    for (int g = 0; g < 2; ++g) {
        float mx = fmaxf(fmaxf(s[g][0][0], s[g][0][1]), fmaxf(s[g][0][2], s[g][0][3]));
#pragma unroll
        for (int kk = 1; kk < 4; ++kk) mx = fmaxf(fmaxf(mx, fmaxf(s[g][kk][0], s[g][kk][1])), fmaxf(s[g][kk][2], s[g][kk][3]));
        mx = xmax16(mx); mx = xmax32(mx);
        if (first) {
            mrun[g] += mx;
#pragma unroll
            for (int kk = 0; kk < 4; ++kk)
#pragma unroll
                for (int r = 0; r < 4; ++r) s[g][kk][r] = __builtin_amdgcn_exp2f(s[g][kk][r] - mx);
        } else if (__any(mx > 0.f)) {
            const float dl = fmaxf(mx, 0.f), alpha = __builtin_amdgcn_exp2f(-dl);
            mrun[g] += dl;
            lacc[g] = lacc[g] * alpha;
#pragma unroll
            for (int v = 0; v < 4; ++v) o[g][v] = o[g][v] * alpha;
#pragma unroll
            for (int kk = 0; kk < 4; ++kk)
#pragma unroll
                for (int r = 0; r < 4; ++r) s[g][kk][r] = __builtin_amdgcn_exp2f(s[g][kk][r] - dl);
        } else {
#pragma unroll
            for (int kk = 0; kk < 4; ++kk)
#pragma unroll
                for (int r = 0; r < 4; ++r) s[g][kk][r] = __builtin_amdgcn_exp2f(s[g][kk][r]);
        }
#pragma unroll
        for (int k2 = 0; k2 < 2; ++k2) {
            u32x4 w; w.x = pk2(s[g][2 * k2][0], s[g][2 * k2][1]); w.y = pk2(s[g][2 * k2][2], s[g][2 * k2][3]);
            w.z = pk2(s[g][2 * k2 + 1][0], s[g][2 * k2 + 1][1]); w.w = pk2(s[g][2 * k2 + 1][2], s[g][2 * k2 + 1][3]);
            pf[g][k2] = __builtin_bit_cast(bf16x8, w);
            lacc[g] = mfma16(ones, pf[g][k2], lacc[g]);
        }
    }
#pragma unroll
    for (int k2 = 0; k2 < 2; ++k2)
#pragma unroll
        for (int v = 0; v < 4; ++v) {
            const u32x2 lo = *(const u32x2*)(Vb + (v * 16 + l15) * 72 + k2 * 32 + quad * 4), hi = *(const u32x2*)(Vb + (v * 16 + l15) * 72 + k2 * 32 + 16 + quad * 4);
            u32x4 w; w.x = lo.x; w.y = lo.y; w.z = hi.x; w.w = hi.y;
            const bf16x8 vf = __builtin_bit_cast(bf16x8, w);
            o[0][v] = mfma16(vf, pf[0][k2], o[0][v]); o[1][v] = mfma16(vf, pf[1][k2], o[1][v]);
        }
}
__device__ __forceinline__ void attn_item(const Args& a, int item, unsigned char* lds) {
    const int tid = otid(), lane = tid & 63, wv = tid >> 6, quad = lane >> 4, l15 = lane & 15;
    int b, h, qb;
    if (item < 512) {
        const int r = item >> 8, c = item & 255, x = c & 7, j = c >> 3, bh = r * 32 + x * 4 + (j >> 3);
        qb = 1 + (j & 7); h = bh & 7; b = bh >> 3;
    } else { const int i2 = item - 512; qb = 0; h = i2 & 7; b = i2 >> 3; }
    const int nkt = qb == 0 ? 4 : NCH;
    unsigned char* mb = a.ws + WS_MLA;
    const bf16_t* Qg = (const bf16_t*)(mb + A_Q) + (size_t)(b * 8 + h) * T * 96;
    const bf16_t* Kg = (const bf16_t*)(mb + A_K) + (size_t)(b * 8 + h) * T * 96;
    const bf16_t* Vg = (const bf16_t*)(mb + A_VT) + (size_t)(h * 64) * M + (size_t)b * T;
    AtIdx x; x.tid = tid; x.kr0 = tid / 12; x.kc0 = tid - x.kr0 * 12; x.kr1 = (tid + 512) / 12; x.kc1 = (tid + 512) - x.kr1 * 12;
    AtRegs ra, rb; ra.k1 = (u32x4){0u, 0u, 0u, 0u}; rb.k1 = ra.k1;
    at_load(ra, Kg, Vg, 0, x); at_load(rb, Kg, Vg, 1, x);
    bf16x8 qf[2][3];
#pragma unroll
    for (int g = 0; g < 2; ++g)
#pragma unroll
        for (int ks = 0; ks < 3; ++ks) qf[g][ks] = *(const bf16x8*)(Qg + (size_t)(qb * 256 + wv * 32 + g * 16 + l15) * 96 + ks * 32 + quad * 8);
    f32x4 o[2][4], lacc[2]; float mrun[2];
#pragma unroll
    for (int g = 0; g < 2; ++g) { mrun[g] = 0.f; lacc[g] = (f32x4){0.f, 0.f, 0.f, 0.f};
#pragma unroll
        for (int v = 0; v < 4; ++v) o[g][v] = (f32x4){0.f, 0.f, 0.f, 0.f}; }
    at_store(ra, lds, 0, x); at_store(rb, lds, 1, x);
    at_load(ra, Kg, Vg, 2, x); at_load(rb, Kg, Vg, 3, x);
    __syncthreads();
#pragma unroll 1
    for (int kt = 0; kt < nkt; kt += 2) {
        const int sw = wv >> 2, b0 = (kt + sw) & 3, b1 = (kt + 1 - sw) & 3;
        attn_tile((const bf16_t*)(lds + b0 * AT_BUF), (const bf16_t*)(lds + b0 * AT_BUF + AT_K), kt == 0, qf, o, lacc, mrun, l15, quad);
        attn_tile((const bf16_t*)(lds + b1 * AT_BUF), (const bf16_t*)(lds + b1 * AT_BUF + AT_K), false, qf, o, lacc, mrun, l15, quad);
        if (kt + 2 < nkt) { at_store(ra, lds, (kt + 2) & 3, x); at_store(rb, lds, (kt + 3) & 3, x); }
        if (kt + 4 < nkt) { at_load(ra, Kg, Vg, kt + 4, x); at_load(rb, Kg, Vg, kt + 5, x); }
        __syncthreads();
    }
    bf16_t* mix = WSP(bf16_t, WS_H);
#pragma unroll
    for (int g = 0; g < 2; ++g) {
        const float inv = 1.0f / lacc[g][0];
        const int t = qb * 256 + wv * 32 + g * 16 + l15;
        bf16_t* dst = mix + ((size_t)b * T + t) * 1024 + 512 + h * 64 + quad * 4;
#pragma unroll
        for (int v = 0; v < 4; ++v) { u32x2 w; w.x = pk2(o[g][v][0] * inv, o[g][v][1] * inv); w.y = pk2(o[g][v][2] * inv, o[g][v][3] * inv); *(u32x2*)(dst + v * 16) = w; }
    }
}
__device__ __forceinline__ void combine_row(const Args& a, int l, int m) {
    const int lane = otid() & 63, hh = lane >> 4, c0 = (lane & 15) * 8;
    const float* Of = WSP(const float, WS_O) + (size_t)m * 512 + hh * 128 + c0; const float* Ob = Of + (size_t)M * 512;
    const f32x4 a0 = *(const f32x4*)Of + *(const f32x4*)Ob, a1 = *(const f32x4*)(Of + 4) + *(const f32x4*)(Ob + 4);
    float ss = a0[0] * a0[0] + a0[1] * a0[1] + a0[2] * a0[2] + a0[3] * a0[3] + a1[0] * a1[0] + a1[1] * a1[1] + a1[2] * a1[2] + a1[3] * a1[3];
#pragma unroll
    for (int o = 8; o >= 1; o >>= 1) ss += __shfl_xor(ss, o);
    const float r = rsqrtf(ss * (1.0f / 128.0f) + EPS);
    const float* gn = a.in[15] + l * 128 + c0;
    const u32x4 zw = *(const u32x4*)(WSP(const bf16_t, WS_P) + (size_t)m * PC + OFF_Z + hh * 128 + c0);
    const float z[8] = {bflo(zw.x), bfhi(zw.x), bflo(zw.y), bfhi(zw.y), bflo(zw.z), bfhi(zw.z), bflo(zw.w), bfhi(zw.w)};
    float v[8];
#pragma unroll
    for (int i = 0; i < 4; ++i) { v[i] = a0[i] * r * gn[i] * silu_f(z[i]); v[4 + i] = a1[i] * r * gn[4 + i] * silu_f(z[4 + i]); }
    u32x4 w; w.x = pk2(v[0], v[1]); w.y = pk2(v[2], v[3]); w.z = pk2(v[4], v[5]); w.w = pk2(v[6], v[7]);
    *(u32x4*)(WSP(bf16_t, WS_H) + (size_t)m * 1024 + hh * 128 + c0) = w;
}

struct RemapOrder {
    pg8::StaticOrder S; int remap;
    __device__ __forceinline__ bool next(int i, pg8::Unit& u) const { const bool r = S.next(i, u); if (r && remap) u.pm = (u.pm >> 3) * 9 + 1 + (u.pm & 7); return r; }
    __device__ __forceinline__ void a_ready(const pg8::Unit&) const {}
    __device__ __forceinline__ void done(const pg8::Unit&) const {}
};
template <class Epi> __device__ __forceinline__ void run_gemm(unsigned char* lds, const bf16_t* A, const bf16_t* Bt, int Mr, int N, int K, int rot, const Epi& E, int latent_only = 0) {
    pg8::Gemm g{A, Bt, Mr, N, K}; RemapOrder S; S.S.init(latent_only ? 64 * 256 : Mr, N, (int)gridDim.x, (int)((blockIdx.x + rot) % gridDim.x)); S.remap = latent_only;
    pg8::gemm_phase<Epi, RemapOrder, true, true>((PG8_LAS unsigned char*)lds, g, S, E);
}
__device__ __forceinline__ void run_gemm_fused(unsigned char* lds, const bf16_t* A, const bf16_t* Bt, int K, const EpiResNorm& E, int latent_only) {
    pg8::Gemm g{A, Bt, M, D, K}; PanelOrder S; S.c = (int)blockIdx.x; S.latent_only = latent_only;
    pg8::gemm_phase<EpiResNorm, PanelOrder, true, true>((PG8_LAS unsigned char*)lds, g, S, E);
}

__global__ void __launch_bounds__(512, 2) mega_fwd(Args a) {
    extern __shared__ __attribute__((aligned(16))) unsigned char lds[];
    cg::grid_group grid = cg::this_grid();
    volatile LAS unsigned* bst = (volatile LAS unsigned*)((LAS unsigned char*)lds + LDS_BYTES - 16);
    if (threadIdx.x < 4) bst[threadIdx.x] = 0u;
    __syncthreads();
    XcdBarrier xbar; xbar.bar = (unsigned*)(a.ws + WS_BAR); xbar.x = 0; xbar.st = nullptr;
    if (a.coop == 1 && blockIdx.x == 0) for (int i = threadIdx.x; i < 5120; i += 512) ((unsigned*)(a.ws + WS_BAR))[i] = 0u;
    unsigned char* wt = a.ws + WS_WT;
    unsigned char* mb = a.ws + WS_MLA;
    const float* mod = WSP(const float, WS_MOD);
    constexpr int LAST_PH = 12 * DEPTH;
#pragma unroll 1
    for (int ph = a.ph_lo; ph < a.ph_hi; ++ph) {
        const int l = (ph - 1) / 12, k = (ph - 1) % 12;
        if (ph > LAST_PH) continue;
        if (ph > 0 && ((k == 0 && l > 0) || k == 3 || k == 9)) continue;
        if (ph == 0) {
            phase_mod(a, lds);
            __syncthreads();
            phase_transpose(a, 0, lds, 0, 296, 0);
        } else if (k == 0) {
            RowCfg c{1, 0, 0, 0, 1, 0, 0, 0, 0.5f};
            phase_rowpass(a, c);
        } else if (k == 1 || k == 10) {
            EpiGU E{WSP(bf16_t, WS_ACT), DFF};
            run_gemm(lds, WSP(const bf16_t, WS_H), (const bf16_t*)(wt + (k == 1 ? WT_GU0 : WT_GU1)), M, 2 * DFF, D, 0, E, (k == 10 && l == DEPTH - 1) ? 1 : 0);
        } else if (k == 2 || k == 8 || k == 11) {
            const int slot = (k == 2) ? 0 : (k == 8 ? 1 : 2);
            const bool fin = (k == 11 && l == DEPTH - 1);
            const int pl = (k == 11) ? l + 1 : l, ps = (k == 11) ? 0 : slot + 1;
            EpiResNorm E;
            E.X = WSP(float, WS_X); E.H = WSP(bf16_t, WS_H); E.out = fin ? a.out : nullptr;
            E.gate_base = mod + (size_t)l * 9 * 9216 + (3 * slot + 2) * 1024; E.gpost = a.in[7] + (size_t)(l * 3 + slot) * D; E.post_w = (k == 8) ? 1.0f : 0.5f;
            E.shift_base = mod + (size_t)(fin ? l : pl) * 9 * 9216 + (3 * ps) * 1024; E.gpre = a.in[6] + (size_t)((fin ? l : pl) * 3 + ps) * D;
            E.slots = WSP(float, WS_XCH); E.cnt = WSP(unsigned, WS_CNT) + (l * 3 + slot) * 72; E.lds = lds;
            const int lat = (l == DEPTH - 1 && k != 2) ? 1 : 0;
            if (k == 8) run_gemm_fused(lds, WSP(const bf16_t, WS_H), (const bf16_t*)(wt + WT_WOUT), D, E, lat);
            else run_gemm_fused(lds, WSP(const bf16_t, WS_ACT), (const bf16_t*)(wt + (k == 2 ? WT_DN0 : WT_DN1)), DFF, E, lat);
            if (k == 2) {
                __syncthreads();
                if (l > 0) phase_transpose(a, l, lds, 192, 208, 32);
                if (l + 1 < DEPTH) phase_transpose(a, l + 1, lds, 0, 88, 32);
            } else if (k == 11 && l + 1 < DEPTH) {
                __syncthreads();
                phase_transpose(a, l + 1, lds, 88, 192, 32);
                phase_transpose(a, l + 1, lds, 208, 296, 32);
            }
        } else if (k == 4) {
            EpiBf16 E{WSP(bf16_t, WS_P), PC};
            run_gemm(lds, WSP(const bf16_t, WS_H), (const bf16_t*)(wt + WT_WIN), M, PC, D, 0, E);
        } else if (k == 5) {
            phase_m1(a, l, lds);
        } else if (k == 6) {
            phase_scan(a, lds);
            __syncthreads();
            { EpiQ E{(bf16_t*)(mb + A_Q), WSP(const float, WS_ROPE), WSP(const float, WS_ROPE) + SEQ * 16};
              run_gemm(lds, (const bf16_t*)(mb + A_CQN), (const bf16_t*)(wt + WT_WUQ), M, 768, 384, 0, E); }
            { EpiK E{(bf16_t*)(mb + A_K)};
              run_gemm(lds, (const bf16_t*)(mb + A_CKVN), (const bf16_t*)(wt + WT_WK), M, 512, 256, 40, E); }
            { EpiBf16 E{(bf16_t*)(mb + A_VT), M};
              run_gemm(lds, (const bf16_t*)(wt + WT_WV), (const bf16_t*)(mb + A_CKVN), 512, M, 256, 152, E); }
        } else if (k == 7) {
            const bool lastl = (l == DEPTH - 1);
            for (int item = blockIdx.x; item < (lastl ? 512 : 576); item += gridDim.x) attn_item(a, item, lds);
            const int wv = otid() >> 6;
            for (int m = blockIdx.x * 8 + wv; m < M; m += gridDim.x * 8) { if (lastl && (m % T) < CTX) continue; combine_row(a, l, m); }
        }
        if (ph + 1 < a.ph_hi && ph < LAST_PH) {
            if (a.coop == 1) {
                if (ph == a.ph_lo) { grid.sync(); xbar = xcd_barrier_post((unsigned*)(a.ws + WS_BAR), bst); }
                else xcd_barrier(xbar);
            }
            else if (a.coop == 2) grid.sync();
        }
    }
}

#ifndef MK_MULTI
#define MK_MULTI 0
#endif
extern "C" void kernel_launch(void* const* d_in, const int* in_sizes, int n_in, void* d_out, int out_size, void* d_ws, size_t ws_size, hipStream_t stream) {
    static int grid = 0;
    if (grid == 0) {
        int dev = 0, cus = 0, per_cu = 0;
        hipGetDevice(&dev);
        hipDeviceGetAttribute(&cus, hipDeviceAttributeMultiprocessorCount, dev);
        hipFuncSetAttribute((const void*)mega_fwd, hipFuncAttributeMaxDynamicSharedMemorySize, LDS_BYTES);
        hipOccupancyMaxActiveBlocksPerMultiprocessor(&per_cu, (const void*)mega_fwd, 512, LDS_BYTES);
        if (per_cu < 1) per_cu = 1;
        if (cus < 1) cus = 256;
        grid = cus * per_cu;
        if (grid > 256) grid = 256;
        (void)hipGetLastError();
        if (ws_size < WS_END) fprintf(stderr, "kernel_launch: workspace too small: %zu < %zu\n", ws_size, (size_t)WS_END);
    }
    Args a{};
    for (int i = 0; i < 21; ++i) a.in[i] = (const float*)d_in[i];
    a.out = (float*)d_out; a.ws = (unsigned char*)d_ws;
#if MK_MULTI
    for (int ph = 0; ph < NPHASE; ++ph) {
        a.ph_lo = ph; a.ph_hi = ph + 1; a.coop = 0;
        hipLaunchKernelGGL(mega_fwd, dim3(grid), dim3(512), LDS_BYTES, stream, a);
    }
#else
    a.ph_lo = 0; a.ph_hi = NPHASE; a.coop = 1;
    void* args[] = {&a};
    hipError_t e = hipLaunchCooperativeKernel((const void*)mega_fwd, dim3(grid), dim3(512), args, LDS_BYTES, stream);
    if (e != hipSuccess) fprintf(stderr, "cooperative launch failed: %s (grid %d)\n", hipGetErrorString(e), grid);
#endif
}
```
